# Optimizing an MI355X kernel written in HIP

```python
import math
import jax, jax.numpy as jnp
from jax import lax
import numpy as np

D_MODEL = 1024
BATCH = 8
SEQ = 4096
DEPTH = 2

HEAD_DIM = 64
A_Q_HEADS = 8
A_KV_HEADS = 2
WINDOW = 128
ROPE_DIM = HEAD_DIM // 4
ROPE_THETA = 500000.0
B_HEADS = 4
B_DK = 64
B_DV = 64
C_HEADS = 4
C_DK = 64
C_DV = 64
CONV_WIDTH = 4
CHUNK = 64
D_FF = -(-8 * D_MODEL // (3 * 256)) * 256
D_MIX = A_Q_HEADS * HEAD_DIM + B_HEADS * B_DV + C_HEADS * C_DV
C_CONV_CH = C_HEADS * (2 * C_DK + C_DV)
IN_SIZES = (A_Q_HEADS * HEAD_DIM, A_KV_HEADS * HEAD_DIM, A_KV_HEADS * HEAD_DIM,
            B_HEADS * B_DK, B_HEADS * B_DK, B_HEADS * B_DV, B_HEADS * B_DV,
            C_CONV_CH, C_HEADS * C_DV, C_HEADS, C_HEADS)
D_IN = sum(IN_SIZES)
NORM_EPS = 1e-6

kernel_name = 'hybrid_swa_hgrn2_gdn_block'


def rmsnorm(x, gain):
    xf = x.astype(jnp.float32)
    y = xf * lax.rsqrt(jnp.mean(xf * xf, axis=-1, keepdims=True) + NORM_EPS)
    return (y * gain.astype(jnp.float32)).astype(x.dtype)


def l2norm(x):
    return x * lax.rsqrt(jnp.sum(x * x, axis=-1, keepdims=True) + NORM_EPS)


def partial_rope(x, positions):
    half = ROPE_DIM // 2
    inv_freq = ROPE_THETA ** (-jnp.arange(half, dtype=jnp.float32) * 2.0 / ROPE_DIM)
    ang = positions.astype(jnp.float32)[..., None] * inv_freq
    cos = jnp.cos(ang)[:, :, None, :]
    sin = jnp.sin(ang)[:, :, None, :]
    xf = x.astype(jnp.float32)
    x1, x2, xp = xf[..., :half], xf[..., half:ROPE_DIM], xf[..., ROPE_DIM:]
    out = jnp.concatenate([x1 * cos - x2 * sin, x2 * cos + x1 * sin, xp], axis=-1)
    return out.astype(x.dtype)


def sliding_window_attention(q, k, v, sinks):
    b, s, hq, d = q.shape
    hkv = k.shape[2]
    grp = hq // hkv
    nb = s // WINDOW
    qb = q.reshape(b, nb, WINDOW, hkv, grp, d)

    def band(t):
        tb = t.reshape(b, nb, WINDOW, hkv, d)
        prev = jnp.concatenate([jnp.zeros_like(tb[:, :1]), tb[:, :-1]], axis=1)
        return jnp.concatenate([prev, tb], axis=2)

    kb, vb = band(k), band(v)
    scores = jnp.einsum('bnqhgd,bnkhd->bnhgqk', qb, kb).astype(jnp.float32) * (d ** -0.5)
    qi = jnp.arange(WINDOW)[:, None]
    kj = jnp.arange(2 * WINDOW)[None, :]
    delta = qi + WINDOW - kj
    blk = jnp.arange(nb)[:, None, None]
    valid = (delta >= 0) & (delta < WINDOW) & (blk * WINDOW + kj - WINDOW >= 0)
    scores = jnp.where(valid[None, :, None, None], scores, -jnp.inf)
    sink = sinks.astype(jnp.float32).reshape(hkv, grp)[None, None, :, :, None, None]
    m = jnp.maximum(scores.max(axis=-1, keepdims=True), sink)
    p = jnp.exp(scores - m)
    denom = p.sum(axis=-1, keepdims=True) + jnp.exp(sink - m)
    out = jnp.einsum('bnhgqk,bnkhd->bnqhgd', (p / denom).astype(v.dtype), vb)
    return out.reshape(b, s, hq * d)


def hgrn2_chunked(q, log_f, v):
    b, s, h, dk = q.shape
    dv = v.shape[-1]
    nc = s // CHUNK

    def to_chunks(t):
        return t.reshape(b, nc, CHUNK, h, t.shape[-1]).transpose(1, 0, 3, 2, 4)

    causal = jnp.tril(jnp.ones((CHUNK, CHUNK), dtype=bool))

    def step(state, inp):
        qt, lf, vt = inp
        kt = -jnp.expm1(lf)
        cum = jnp.cumsum(lf, axis=2)
        diff = cum[:, :, :, None, :] - cum[:, :, None, :, :]
        decay = jnp.exp(jnp.where(causal[:, :, None], diff, -jnp.inf))
        attn = jnp.einsum('bhtd,bhsd,bhtsd->bhts', qt, kt, decay)
        o = attn @ vt + jnp.einsum('bhtd,bhde->bhte', qt * jnp.exp(cum), state)
        last = cum[:, :, -1:, :]
        state = jnp.exp(last[:, :, 0, :, None]) * state + jnp.einsum('bhsd,bhse->bhde', kt * jnp.exp(last - cum), vt)
        return state, o

    state0 = jnp.zeros((b, h, dk, dv), jnp.float32)
    _, o = lax.scan(step, state0, (to_chunks(q), to_chunks(log_f), to_chunks(v)))
    return o.transpose(1, 0, 3, 2, 4).reshape(b, s, h, dv)


def causal_depthwise_conv(x, w):
    ch = x.shape[-1]
    return lax.conv_general_dilated(x, w[:, None, :].astype(x.dtype), window_strides=(1,),
                                    padding=[(CONV_WIDTH - 1, 0)],
                                    dimension_numbers=('NWC', 'WIO', 'NWC'),
                                    feature_group_count=ch)


def gated_delta_chunked(q, k, v, beta, g):
    b, s, h, dk = q.shape
    dv = v.shape[-1]
    nc = s // CHUNK

    def to_chunks(t):
        return jnp.swapaxes(t.reshape((b, nc, CHUNK) + t.shape[2:]), 2, 3)

    qc, kc, vc, bc, gc = (to_chunks(t) for t in (q, k, v, beta, g))
    G = jnp.cumsum(gc, axis=-1)
    incl = jnp.tril(jnp.ones((CHUNK, CHUNK), dtype=bool))
    strict = jnp.tril(jnp.ones((CHUNK, CHUNK), dtype=bool), k=-1)
    L = jnp.exp(jnp.where(incl, G[..., :, None] - G[..., None, :], -jnp.inf))
    kb = kc * bc[..., None]
    A = jnp.where(strict, jnp.einsum('bnhtd,bnhsd->bnhts', kb, kc) * L, 0.0)
    eye = jnp.eye(CHUNK, dtype=jnp.float32)
    T = lax.linalg.triangular_solve(eye + A, jnp.broadcast_to(eye, A.shape), left_side=True,
                                    lower=True, unit_diagonal=True)
    U = T @ (vc * bc[..., None])
    W = T @ (kb * jnp.exp(G)[..., None])
    qk = jnp.where(incl, jnp.einsum('bnhtd,bnhsd->bnhts', qc, kc) * L, 0.0)
    q_dec = qc * jnp.exp(G)[..., None]
    k_dec = kc * jnp.exp(G[..., -1:] - G)[..., None]
    g_last = jnp.exp(G[..., -1])

    def step(state, inp):
        u, w, qd, kd, qkc, gl = inp
        v_new = u - w @ state
        o = qd @ state + qkc @ v_new
        state = gl[..., None, None] * state + jnp.swapaxes(kd, -1, -2) @ v_new
        return state, o

    xs = tuple(jnp.moveaxis(t, 1, 0) for t in (U, W, q_dec, k_dec, qk, g_last))
    state0 = jnp.zeros((b, h, dk, dv), jnp.float32)
    _, o = lax.scan(step, state0, xs)
    return jnp.swapaxes(jnp.moveaxis(o, 0, 1), 2, 3).reshape(b, s, h, dv)


def hybrid_mixer(h, positions, w_in, q_norm, k_norm, sinks, lb, hgrn_norm, conv_w, a_log, dt_bias,
                 gdn_norm, w_out):
    b, s, _ = h.shape
    f32 = jnp.float32
    proj = h @ w_in
    split_at = [int(i) for i in np.cumsum(IN_SIZES)[:-1]]
    aq, ak, av, bq, bf, bv, bg, cqkv, cg, cb, ca = jnp.split(proj, split_at, axis=-1)

    aq = partial_rope(rmsnorm(aq.reshape(b, s, A_Q_HEADS, HEAD_DIM), q_norm), positions)
    ak = partial_rope(rmsnorm(ak.reshape(b, s, A_KV_HEADS, HEAD_DIM), k_norm), positions)
    av = av.reshape(b, s, A_KV_HEADS, HEAD_DIM)
    out_a = sliding_window_attention(aq, ak, av, sinks)

    lb = lb.astype(f32).reshape(B_HEADS, B_DK)
    z = bf.reshape(b, s, B_HEADS, B_DK).astype(f32)
    log_f = jnp.logaddexp(jnp.log(lb), jnp.log1p(-lb) + jax.nn.log_sigmoid(z))
    o_b = hgrn2_chunked(bq.reshape(b, s, B_HEADS, B_DK).astype(f32), log_f,
                        bv.reshape(b, s, B_HEADS, B_DV).astype(f32))
    out_b = rmsnorm(o_b, hgrn_norm) * jax.nn.silu(bg.reshape(b, s, B_HEADS, B_DV).astype(f32))
    out_b = out_b.reshape(b, s, B_HEADS * B_DV).astype(h.dtype)

    cqkv = jax.nn.silu(causal_depthwise_conv(cqkv, conv_w))
    cq, ck, cv = jnp.split(cqkv, [C_HEADS * C_DK, 2 * C_HEADS * C_DK], axis=-1)
    cq = l2norm(cq.reshape(b, s, C_HEADS, C_DK).astype(f32)) * (C_DK ** -0.5)
    ck = l2norm(ck.reshape(b, s, C_HEADS, C_DK).astype(f32))
    cv = cv.reshape(b, s, C_HEADS, C_DV).astype(f32)
    beta = jax.nn.sigmoid(cb.astype(f32))
    g = -jnp.exp(a_log.astype(f32)) * jax.nn.softplus(ca.astype(f32) + dt_bias.astype(f32))
    o_c = gated_delta_chunked(cq, ck, cv, beta, g)
    out_c = rmsnorm(o_c, gdn_norm) * jax.nn.silu(cg.reshape(b, s, C_HEADS, C_DV).astype(f32))
    out_c = out_c.reshape(b, s, C_HEADS * C_DV).astype(h.dtype)

    mixed = jnp.concatenate([out_a, out_b, out_c], axis=-1)
    return mixed @ w_out


def swiglu(h, w_gate, w_up, w_down):
    return (jax.nn.silu(h @ w_gate) * (h @ w_up)) @ w_down


def setup_inputs(seed: int = 0) -> dict:
    key = jax.random.key(seed)
    ks = jax.random.split(key, 24)
    f32 = jnp.float32

    def nrm(k, shape, scale):
        return jax.random.normal(k, shape, f32) * scale

    x = nrm(ks[0], (BATCH, SEQ, D_MODEL), 1.0)
    c = nrm(ks[1], (BATCH, D_MODEL), 1.0)
    positions = jnp.broadcast_to(jnp.arange(SEQ, dtype=jnp.int32)[None, :], (BATCH, SEQ))
    ada_w = nrm(ks[2], (DEPTH, D_MODEL, 6 * D_MODEL), 0.5 * D_MODEL ** -0.5)
    ada_b = nrm(ks[3], (DEPTH, 6 * D_MODEL), 0.02)
    norm_mix = 1.0 + nrm(ks[4], (DEPTH, D_MODEL), 0.05)
    w_in = nrm(ks[5], (DEPTH, D_MODEL, D_IN), D_MODEL ** -0.5)
    attn_q_norm = 1.0 + nrm(ks[6], (DEPTH, HEAD_DIM), 0.05)
    attn_k_norm = 1.0 + nrm(ks[7], (DEPTH, HEAD_DIM), 0.05)
    attn_sinks = nrm(ks[8], (DEPTH, A_Q_HEADS), 1.0)
    hgrn_lb_logits = nrm(ks[9], (DEPTH, B_HEADS * B_DK), 1.0)
    hgrn_out_norm = 1.0 + nrm(ks[10], (DEPTH, B_DV), 0.05)
    gdn_conv_w = nrm(ks[11], (DEPTH, CONV_WIDTH, C_CONV_CH), CONV_WIDTH ** -0.5)
    gdn_a_log = jnp.log(jax.random.uniform(ks[12], (DEPTH, C_HEADS), f32, 1.0, 16.0))
    dt = jnp.exp(jax.random.uniform(ks[13], (DEPTH, C_HEADS), f32, math.log(1e-3), math.log(1e-1)))
    gdn_dt_bias = dt + jnp.log(-jnp.expm1(-dt))
    gdn_out_norm = 1.0 + nrm(ks[14], (DEPTH, C_DV), 0.05)
    w_out = nrm(ks[15], (DEPTH, D_MIX, D_MODEL), D_MIX ** -0.5)
    norm_ffn = 1.0 + nrm(ks[16], (DEPTH, D_MODEL), 0.05)
    w_gate = nrm(ks[17], (DEPTH, D_MODEL, D_FF), D_MODEL ** -0.5)
    w_up = nrm(ks[18], (DEPTH, D_MODEL, D_FF), D_MODEL ** -0.5)
    w_down = nrm(ks[19], (DEPTH, D_FF, D_MODEL), D_FF ** -0.5)
    return {'x': x, 'c': c, 'positions': positions, 'ada_w': ada_w, 'ada_b': ada_b,
            'norm_mix': norm_mix, 'w_in': w_in, 'attn_q_norm': attn_q_norm,
            'attn_k_norm': attn_k_norm, 'attn_sinks': attn_sinks, 'hgrn_lb_logits': hgrn_lb_logits,
            'hgrn_out_norm': hgrn_out_norm, 'gdn_conv_w': gdn_conv_w, 'gdn_a_log': gdn_a_log,
            'gdn_dt_bias': gdn_dt_bias, 'gdn_out_norm': gdn_out_norm, 'w_out': w_out,
            'norm_ffn': norm_ffn, 'w_gate': w_gate, 'w_up': w_up, 'w_down': w_down}


def reference(x, c, positions, ada_w, ada_b, norm_mix, w_in, attn_q_norm, attn_k_norm, attn_sinks,
              hgrn_lb_logits, hgrn_out_norm, gdn_conv_w, gdn_a_log, gdn_dt_bias, gdn_out_norm, w_out,
              norm_ffn, w_gate, w_up, w_down):
    lb_cum = jnp.cumsum(jax.nn.softmax(hgrn_lb_logits.astype(jnp.float32), axis=0), axis=0)
    lower_bounds = lb_cum - lb_cum[:1]
    cond = jax.nn.silu(c)
    for l in range(DEPTH):
        mod = cond @ ada_w[l] + ada_b[l]
        sh_m, sc_m, gt_m, sh_f, sc_f, gt_f = [m[:, None, :] for m in jnp.split(mod, 6, axis=-1)]
        h = rmsnorm(x, norm_mix[l]) * (1 + sc_m) + sh_m
        y = hybrid_mixer(h, positions, w_in[l], attn_q_norm[l], attn_k_norm[l], attn_sinks[l],
                         lower_bounds[l], hgrn_out_norm[l], gdn_conv_w[l], gdn_a_log[l],
                         gdn_dt_bias[l], gdn_out_norm[l], w_out[l])
        x = x + gt_m * y
        h = rmsnorm(x, norm_ffn[l]) * (1 + sc_f) + sh_f
        x = x + gt_f * swiglu(h, w_gate[l], w_up[l], w_down[l])
    return x
```

```cpp
#include <hip/hip_runtime.h>
#include <hip/hip_cooperative_groups.h>
#include <cstdio>
#include <cstdint>
namespace cg = cooperative_groups;

__device__ __forceinline__ int opq_tid() { int t = threadIdx.x; asm volatile("" : "+v"(t)); return t; }
__device__ __forceinline__ int opq_bid() { int t = blockIdx.x; asm volatile("" : "+s"(t)); return t; }
__device__ __forceinline__ int opq_gdim() { int t = gridDim.x; asm volatile("" : "+s"(t)); return t; }
namespace pg8 {
#define PG8_LAS __attribute__((address_space(3)))
typedef unsigned short bf16_t;
typedef short bf16x8 __attribute__((ext_vector_type(8)));
typedef float f32x4 __attribute__((ext_vector_type(4)));
typedef unsigned u32x4 __attribute__((ext_vector_type(4)));
constexpr int BM = 256, BK = 64, HALF = 128, HTB = HALF * BK * 2  , STAGE_BYTES = 8 * HTB, NXCD = 8, WGM = 8;

__host__ __device__ __forceinline__ int lds_byte(int r, int c) { const int st = (r >> 4) * 2 + (c >> 5), rr = r & 15, cc = c & 31, ob = rr * 64 + cc * 2; return st * 1024 + (ob ^ (((ob >> 9) & 1) << 5)); }
__host__ __device__ __forceinline__ void stage_rc(int b, int& R, int& C) { const int st = b / 1024, sb = b % 1024, swz = sb ^ (((sb >> 9) & 1) << 5); R = (st >> 1) * 16 + swz / 64; C = (st & 1) * 32 + (swz % 64) / 2; }
__host__ __device__ __forceinline__ int perm32(int rho) { const int n = rho >> 4, i = rho & 15; return 8 * (i >> 2) + 4 * n + (i & 3); }

struct Unit { int pm, pn; };
struct Gemm { const bf16_t* A; const bf16_t* Bt; int M, N, K; };

struct StaticOrder {
    int nM, nN, nwg, G, c;
    __host__ __device__ void init(int M, int N, int G_, int c_) { nM = M / BM; nN = N / BM; nwg = nM * nN; G = G_; c = c_; }
    __host__ __device__ bool next(int i, Unit& u) const {
        const long L = (long)i * G + c; if (L >= nwg) return false;
        int wgid = (int)L; { const int q = nwg / NXCD, r = nwg % NXCD, xcd = wgid % NXCD, off = wgid / NXCD; wgid = (xcd < r ? xcd * (q + 1) : r * (q + 1) + (xcd - r) * q) + off; }
        const int nig = WGM * nN, gid = wgid / nig, fm = gid * WGM, gsz = (nM - fm) < WGM ? (nM - fm) : WGM;
        u.pm = fm + ((wgid % nig) % gsz); u.pn = (wgid % nig) / gsz; return true;
    }
    __device__ __forceinline__ void a_ready(const Unit&) const {}
    __device__ __forceinline__ void done(const Unit&) const {}
};

__device__ __forceinline__ unsigned cvt_pk_bf16(float lo, float hi) { unsigned r; asm volatile("v_cvt_pk_bf16_f32 %0, %1, %2" : "=v"(r) : "v"(lo), "v"(hi)); return r; }
typedef float f32x2 __attribute__((ext_vector_type(2)));
__device__ __forceinline__ f32x2 gelu_pk(f32x2 v) {
    const f32x2 av = __builtin_elementwise_abs(v), d = av * 0.2316418882f + 1.0f;
    f32x2 t; t.x = __builtin_amdgcn_rcpf(d.x); t.y = __builtin_amdgcn_rcpf(d.y);
    f32x2 q = t * 0.5307027145f + (-0.7265760135f); q = q * t + 0.7107068705f; q = q * t + (-0.142248368f); q = q * t + 0.127414796f; q = q * t;
    const f32x2 s = (v * v) * (-0.72134752044f);
    f32x2 e; e.x = __builtin_amdgcn_exp2f(s.x); e.y = __builtin_amdgcn_exp2f(s.y);
    const f32x2 m = v * (q * e), r = v - m;
    f32x2 o; o.x = v.x < 0.f ? m.x : r.x; o.y = v.y < 0.f ? m.y : r.y; return o;
}

struct EpiStoreBf16 {
    static constexpr bool PERM = true, AFTER_DRAIN = false;
    bf16_t* O; int ldc;
    __device__ __forceinline__ void operator()(const f32x4 (&acc)[2][2][4][2], const Unit& u, int wr, int wc, int fr, int fq) const {
        const int row0 = u.pm * BM + wr * 64 + fr, col0 = u.pn * BM + wc * 32 + 8 * fq;
#pragma unroll
        for (int ai = 0; ai < 2; ++ai)
#pragma unroll
            for (int m = 0; m < 4; ++m) { bf16_t* rowp = O + (size_t)(row0 + ai * HALF + m * 16) * ldc + col0;
#pragma unroll
                for (int bj = 0; bj < 2; ++bj) { const f32x4 v0 = acc[ai][bj][m][0], v1 = acc[ai][bj][m][1];
                    u32x4 w; w.x = cvt_pk_bf16(v0[0], v0[1]); w.y = cvt_pk_bf16(v0[2], v0[3]); w.z = cvt_pk_bf16(v1[0], v1[1]); w.w = cvt_pk_bf16(v1[2], v1[3]);
                    *(u32x4*)(rowp + bj * HALF) = w; } }
    }
};
struct EpiSwiGlu {
    static constexpr bool PERM = true, AFTER_DRAIN = false;
    bf16_t* O; int ldc;
    __device__ __forceinline__ void operator()(const f32x4 (&acc)[2][2][4][2], const Unit& u, int wr, int wc, int fr, int fq) const {
        const int row0 = u.pm * BM + wr * 64 + fr, col0 = u.pn * HALF + wc * 32 + 8 * fq;
#pragma unroll
        for (int ai = 0; ai < 2; ++ai)
#pragma unroll
            for (int m = 0; m < 4; ++m) { bf16_t* rowp = O + (size_t)(row0 + ai * HALF + m * 16) * ldc + col0;
                float r[8];
#pragma unroll
                for (int n = 0; n < 2; ++n)
#pragma unroll
                    for (int i = 0; i < 4; ++i) { const float g = acc[ai][0][m][n][i], up = acc[ai][1][m][n][i]; r[n * 4 + i] = g * __builtin_amdgcn_rcpf(1.0f + __expf(-g)) * up; }
                u32x4 w; w.x = cvt_pk_bf16(r[0], r[1]); w.y = cvt_pk_bf16(r[2], r[3]); w.z = cvt_pk_bf16(r[4], r[5]); w.w = cvt_pk_bf16(r[6], r[7]);
                *(u32x4*)rowp = w; }
    }
};
struct EpiGateRes {
    static constexpr bool PERM = false, AFTER_DRAIN = false;
    const float* base; float* out; int ldc; const float* gate; int gate_stride; int rows_per_batch;
    __device__ __forceinline__ void operator()(const f32x4 (&acc)[2][2][4][2], const Unit& u, int wr, int wc, int fr, int fq) const {
        const int col0 = u.pn * BM + wc * 32 + 4 * fq;
        const float* gp = gate + (size_t)((u.pm * BM) / rows_per_batch) * gate_stride + col0;
        f32x4 gv[2][2];
#pragma unroll
        for (int bj = 0; bj < 2; ++bj)
#pragma unroll
            for (int n = 0; n < 2; ++n) gv[bj][n] = *(const f32x4*)(gp + bj * HALF + n * 16);
#pragma unroll
        for (int ai = 0; ai < 2; ++ai)
#pragma unroll
            for (int mp = 0; mp < 2; ++mp) {
                f32x4 pre[2][2][2];
#pragma unroll
                for (int mm = 0; mm < 2; ++mm) { const size_t off = (size_t)(u.pm * BM + ai * HALF + wr * 64 + (2 * mp + mm) * 16 + fr) * ldc + col0;
#pragma unroll
                    for (int bj = 0; bj < 2; ++bj)
#pragma unroll
                        for (int n = 0; n < 2; ++n) pre[mm][bj][n] = *(const f32x4*)(base + off + bj * HALF + n * 16); }
#pragma unroll
                for (int mm = 0; mm < 2; ++mm) { const size_t off = (size_t)(u.pm * BM + ai * HALF + wr * 64 + (2 * mp + mm) * 16 + fr) * ldc + col0;
#pragma unroll
                    for (int bj = 0; bj < 2; ++bj)
#pragma unroll
                        for (int n = 0; n < 2; ++n) *(f32x4*)(out + off + bj * HALF + n * 16) = pre[mm][bj][n] + gv[bj][n] * acc[ai][bj][2 * mp + mm][n]; }
                asm volatile("" ::: "memory");
            }
    }
};
template <class Epi, class Sched, bool ALIGN_EPI = false, bool SP2 = false>
__device__ __forceinline__ void gemm_phase(PG8_LAS unsigned char* lds, const Gemm g, const Sched& S, const Epi& E) {
    const int tid = opq_tid(), wid = __builtin_amdgcn_readfirstlane(tid >> 6), lane = tid & 63, wr = wid >> 2, wc = wid & 3, fr = lane & 15, fq = lane >> 4;
    const int K = g.K, nt = K / BK;
    unsigned voffA[2], voffB[2];
#pragma unroll
    for (int i = 0; i < 2; ++i) { int R, C; stage_rc(tid * 16 + i * 8192, R, C); const int Rb = Epi::PERM ? ((R & ~31) + perm32(R & 31)) : R;
        voffA[i] = (unsigned)(R * K + C) * 2u; voffB[i] = (unsigned)(Rb * K + C) * 2u; }
    const size_t kstep = (size_t)(BK * 2);
    const size_t hstep = (size_t)HALF * K * 2;
    const size_t tstep = 2 * hstep;
    const unsigned ldsw = (unsigned)wid * 1024u;
    const int aoff = lds_byte(wr * 64 + fr, fq * 8), boff = lds_byte(wc * 32 + fr, fq * 8);
#define PG8_SA(b, h) (((b) * 2 + (h)) * HTB)
#define PG8_SB(b, h) ((4 + (b) * 2 + (h)) * HTB)
#define PG8_STAGE(bufoff, gbase, voff) do { _Pragma("unroll") for (int _i = 0; _i < 2; ++_i) \
        __builtin_amdgcn_global_load_lds((const unsigned*)((const char*)(gbase) + (voff)[_i]), (PG8_LAS unsigned*)(lds + (bufoff) + ldsw + _i * 8192), 16, 0, 0); } while (0)
#define PG8_LDA(dst, b, h) do { _Pragma("unroll") for (int m = 0; m < 4; ++m) _Pragma("unroll") for (int k = 0; k < 2; ++k) dst[m][k] = *(const PG8_LAS bf16x8*)(lds + PG8_SA(b, h) + aoff + m * 2048 + k * 1024); } while (0)
#define PG8_LDB(dst, b, h) do { _Pragma("unroll") for (int n = 0; n < 2; ++n) _Pragma("unroll") for (int k = 0; k < 2; ++k) dst[n][k] = *(const PG8_LAS bf16x8*)(lds + PG8_SB(b, h) + boff + n * 2048 + k * 1024); } while (0)
#define PG8_MMA(ai, bj, At, Bt) do { __builtin_amdgcn_s_setprio(1); _Pragma("unroll") for (int m = 0; m < 4; ++m) _Pragma("unroll") for (int n = 0; n < 2; ++n) _Pragma("unroll") for (int k = 0; k < 2; ++k) \
        acc[ai][bj][m][n] = __builtin_amdgcn_mfma_f32_16x16x32_bf16(Bt[n][k], At[m][k], acc[ai][bj][m][n], 0, 0, 0); __builtin_amdgcn_s_setprio(0); } while (0)
#define PG8_WAIT_V(n) asm volatile("s_waitcnt vmcnt(" #n ")" ::: "memory")
#define PG8_WAIT_L(n) asm volatile("s_waitcnt lgkmcnt(" #n ")" ::: "memory")
#define PG8_BAR __builtin_amdgcn_s_barrier()
#define PG8_SCHED __builtin_amdgcn_sched_barrier(0)
    Unit cur, nxt; int ui = 0;
    if (!S.next(0, cur)) return;
    f32x4 acc[2][2][4][2];
#pragma unroll
    for (int a = 0; a < 2; ++a)
#pragma unroll
        for (int b = 0; b < 2; ++b)
#pragma unroll
            for (int m = 0; m < 4; ++m)
#pragma unroll
                for (int n = 0; n < 2; ++n) acc[a][b][m][n] = (f32x4){0.f, 0.f, 0.f, 0.f};
    bf16x8 At[4][2], B0[2][2], B1[2][2];
    const char* cA = (const char*)g.A + (size_t)cur.pm * tstep; const char* cB = (const char*)g.Bt + (size_t)cur.pn * tstep;
    S.a_ready(cur);
    if constexpr (SP2) {
        PG8_STAGE(PG8_SB(0, 0), cB, voffB); PG8_STAGE(PG8_SB(0, 1), cB + hstep, voffB); PG8_STAGE(PG8_SA(0, 0), cA, voffA); PG8_STAGE(PG8_SA(0, 1), cA + hstep, voffA);
        if (wr == 1) PG8_BAR;
        PG8_WAIT_V(2); PG8_BAR;
        PG8_STAGE(PG8_SB(1, 0), cB + kstep, voffB); PG8_STAGE(PG8_SA(1, 0), cA + kstep, voffA); PG8_STAGE(PG8_SB(1, 1), cB + hstep + kstep, voffB);
        PG8_WAIT_V(6); PG8_BAR;
    } else {
        PG8_STAGE(PG8_SB(0, 0), cB, voffB); PG8_STAGE(PG8_SA(0, 0), cA, voffA); PG8_STAGE(PG8_SB(0, 1), cB + hstep, voffB); PG8_STAGE(PG8_SA(0, 1), cA + hstep, voffA);
        if (wr == 1) PG8_BAR;
        PG8_WAIT_V(4); PG8_BAR;
        PG8_STAGE(PG8_SB(1, 0), cB + kstep, voffB); PG8_STAGE(PG8_SA(1, 0), cA + kstep, voffA); PG8_STAGE(PG8_SB(1, 1), cB + hstep + kstep, voffB);
        PG8_WAIT_V(6); PG8_BAR;
    }
    for (;;) {
        const bool has_next = S.next(ui + 1, nxt);
        const char* nA = has_next ? (const char*)g.A + (size_t)nxt.pm * tstep : cA; const char* nB = has_next ? (const char*)g.Bt + (size_t)nxt.pn * tstep : cB;
        for (int t = 0; t < nt; t += 2) {
            const bool last = (t == nt - 2);
            const char* a1 = cA + (size_t)(t + 1) * kstep;
            const char* a2 = last ? nA : cA + (size_t)(t + 2) * kstep; const char* b2 = last ? nB : cB + (size_t)(t + 2) * kstep;
            const char* a3 = a2 + kstep; const char* b3 = b2 + kstep;
            if (last && has_next) S.a_ready(nxt);
            if constexpr (SP2) {
            PG8_LDB(B0, 0, 0); PG8_LDB(B1, 0, 1); PG8_SCHED; PG8_LDA(At, 0, 0); PG8_STAGE(PG8_SA(1, 1), a1 + hstep, voffA);
            PG8_WAIT_V(8); PG8_WAIT_L(0); PG8_BAR; PG8_MMA(0, 0, At, B0); PG8_MMA(0, 1, At, B1); PG8_BAR; PG8_SCHED;
            PG8_LDA(At, 0, 1); PG8_STAGE(PG8_SB(0, 0), b2, voffB); PG8_STAGE(PG8_SB(0, 1), b2 + hstep, voffB); PG8_STAGE(PG8_SA(0, 0), a2, voffA);
            PG8_WAIT_V(8); PG8_WAIT_L(0); PG8_BAR; PG8_MMA(1, 0, At, B0); PG8_MMA(1, 1, At, B1); PG8_BAR; PG8_SCHED;
            PG8_LDB(B0, 1, 0); PG8_LDB(B1, 1, 1); PG8_SCHED; PG8_LDA(At, 1, 0); PG8_STAGE(PG8_SA(0, 1), a2 + hstep, voffA);
            PG8_WAIT_V(8); PG8_WAIT_L(0); PG8_BAR; PG8_MMA(0, 0, At, B0); PG8_MMA(0, 1, At, B1); PG8_BAR; PG8_SCHED;
            PG8_LDA(At, 1, 1); PG8_STAGE(PG8_SB(1, 0), b3, voffB); PG8_STAGE(PG8_SB(1, 1), b3 + hstep, voffB); PG8_STAGE(PG8_SA(1, 0), a3, voffA);
            PG8_WAIT_V(8); PG8_WAIT_L(0); PG8_BAR; PG8_MMA(1, 0, At, B0); PG8_MMA(1, 1, At, B1); PG8_BAR; PG8_SCHED;
            } else {
            PG8_LDB(B0, 0, 0); PG8_SCHED; PG8_LDA(At, 0, 0); PG8_STAGE(PG8_SA(1, 1), a1 + hstep, voffA);
            PG8_WAIT_L(8); PG8_BAR; PG8_WAIT_L(0); PG8_MMA(0, 0, At, B0); PG8_BAR; PG8_SCHED;
            PG8_LDB(B1, 0, 1); PG8_STAGE(PG8_SB(0, 0), b2, voffB);
            PG8_BAR; PG8_WAIT_L(0); PG8_MMA(0, 1, At, B1); PG8_BAR;
            PG8_LDA(At, 0, 1); PG8_STAGE(PG8_SA(0, 0), a2, voffA);
            PG8_BAR; PG8_WAIT_L(0); PG8_MMA(1, 0, At, B0); PG8_BAR; PG8_SCHED;
            PG8_STAGE(PG8_SB(0, 1), b2 + hstep, voffB);
            PG8_WAIT_V(6); PG8_BAR; PG8_MMA(1, 1, At, B1); PG8_BAR;
            PG8_LDB(B0, 1, 0); PG8_SCHED; PG8_LDA(At, 1, 0); PG8_STAGE(PG8_SA(0, 1), a2 + hstep, voffA);
            PG8_WAIT_L(8); PG8_BAR; PG8_WAIT_L(0); PG8_MMA(0, 0, At, B0); PG8_BAR; PG8_SCHED;
            PG8_LDB(B1, 1, 1); PG8_STAGE(PG8_SB(1, 0), b3, voffB);
            PG8_BAR; PG8_WAIT_L(0); PG8_MMA(0, 1, At, B1); PG8_BAR;
            PG8_LDA(At, 1, 1); PG8_STAGE(PG8_SA(1, 0), a3, voffA);
            PG8_BAR; PG8_WAIT_L(0); PG8_MMA(1, 0, At, B0); PG8_BAR; PG8_SCHED;
            PG8_STAGE(PG8_SB(1, 1), b3 + hstep, voffB);
            PG8_WAIT_V(6); PG8_BAR; PG8_MMA(1, 1, At, B1); PG8_BAR;
            }
        }
        if constexpr (ALIGN_EPI) { if (wr == 0) PG8_BAR; }
        if constexpr (!Epi::AFTER_DRAIN) { E(acc, cur, wr, wc, fr, fq); S.done(cur); }
        if (!has_next) break;
#pragma unroll
        for (int a = 0; a < 2; ++a)
#pragma unroll
            for (int b = 0; b < 2; ++b)
#pragma unroll
                for (int m = 0; m < 4; ++m)
#pragma unroll
                    for (int n = 0; n < 2; ++n) acc[a][b][m][n] = (f32x4){0.f, 0.f, 0.f, 0.f};
        cur = nxt; cA = nA; cB = nB; ++ui;
        if constexpr (ALIGN_EPI) { if (wr == 1) PG8_BAR; }
    }
    PG8_WAIT_V(0);
    if constexpr (!ALIGN_EPI) { if (wr == 0) PG8_BAR; }
    PG8_BAR;
    if constexpr (Epi::AFTER_DRAIN) { E.fused(acc, cur, wr, wc, fr, fq, lds, wid, lane); S.done(cur); }
#undef PG8_SA
#undef PG8_SB
#undef PG8_STAGE
#undef PG8_LDA
#undef PG8_LDB
#undef PG8_MMA
#undef PG8_WAIT_V
#undef PG8_WAIT_L
#undef PG8_BAR
#undef PG8_SCHED
}
}

#define DI __device__ __forceinline__
#define LAS __attribute__((address_space(3)))
using pg8::bf16_t; using pg8::bf16x8; using pg8::f32x4; using pg8::u32x4; using pg8::cvt_pk_bf16;
typedef short s16x4 __attribute__((ext_vector_type(4)));
typedef unsigned u32x2 __attribute__((ext_vector_type(2)));


constexpr int NB = 8, SEQ = 4096, DM = 1024, MT = NB * SEQ;
constexpr int DIN = 2824, NP = 2816, DFF = 2816;
constexpr int C_AQ = 0, C_AK = 512, C_AV = 640, C_BQ = 768, C_BF = 1024, C_BV = 1280, C_BG = 1536, C_CQ = 1792, C_CK = 2048, C_CV = 2304, C_CG = 2560;
constexpr int NUNIT = NB * 64 * 4;
constexpr float EPS = 1e-6f;
constexpr int LDS_BYTES = 147456;
constexpr int LDS_MISC = LDS_BYTES - 256;
constexpr int NPHASE = 19;
#ifndef PH_MASK
#define PH_MASK 0x3ff
#endif
#define EN(k) (((PH_MASK) >> (k)) & 1)

constexpr size_t MiB = 1u << 20;
constexpr size_t WS_BAR = 512 * 1024;
constexpr size_t WS_MOD = 0, WS_ROPE = 1 * MiB, WS_BGATE = 3 * MiB, WS_W = 4 * MiB, WS_H = 52 * MiB, WS_PROJ = 116 * MiB, WS_BST = 292 * MiB, WS_BDEC = 324 * MiB,
                 WS_CGL = 325 * MiB, WS_CU = 326 * MiB, WS_CW = 358 * MiB, WS_CKD = 390 * MiB, WS_CQD = 406 * MiB, WS_CQK = 422 * MiB, WS_CO = 438 * MiB, WS_BST2 = 470 * MiB, WS_END = 502 * MiB;
constexpr size_t W_IN = 0, W_OUT = (size_t)2816 * 1024, W_GU = W_OUT + (size_t)1024 * 1024, W_DN = W_GU + (size_t)5632 * 1024, W_LAYER = W_DN + (size_t)1024 * 2816;

struct Params {
    const float *x, *c; const int* pos; const float *ada_w, *ada_b, *norm_mix, *w_in, *qn, *kn, *sinks, *lb_logits, *hgrn_norm, *conv_w, *a_log, *dt_bias, *gdn_norm, *w_out,
        *norm_ffn, *w_gate, *w_up, *w_down;
    float* out; unsigned char* ws; int ph_lo, ph_hi;
};

DI float bf2f(bf16_t v) { return __uint_as_float((unsigned)v << 16); }
DI bf16_t f2bf(float f) { const unsigned u = __float_as_uint(f); return (bf16_t)((u + 0x7fffu + ((u >> 16) & 1u)) >> 16); }
#define LDS_BARRIER() do { asm volatile("s_waitcnt lgkmcnt(0)" ::: "memory"); __builtin_amdgcn_s_barrier(); asm volatile("" ::: "memory"); } while (0)
DI float wave_sum(float v) {
#pragma unroll
    for (int o = 32; o >= 1; o >>= 1) v += __shfl_xor(v, o);
    return v;
}
DI float fexp(float x) { return __expf(x); }
DI float frcp(float x) { return __builtin_amdgcn_rcpf(x); }
DI float row16_sum(float s) {
    s += __int_as_float(__builtin_amdgcn_mov_dpp(__float_as_int(s), 0x128, 0xf, 0xf, false));
    s += __int_as_float(__builtin_amdgcn_mov_dpp(__float_as_int(s), 0x124, 0xf, 0xf, false));
    s += __int_as_float(__builtin_amdgcn_mov_dpp(__float_as_int(s), 0x122, 0xf, 0xf, false));
    s += __int_as_float(__builtin_amdgcn_mov_dpp(__float_as_int(s), 0x121, 0xf, 0xf, false));
    return s;
}
DI float wave_sum_dpp(float v) {
    v += __int_as_float(__builtin_amdgcn_mov_dpp(__float_as_int(v), 0xB1, 0xf, 0xf, false));
    v += __int_as_float(__builtin_amdgcn_mov_dpp(__float_as_int(v), 0x4E, 0xf, 0xf, false));
    v += __int_as_float(__builtin_amdgcn_mov_dpp(__float_as_int(v), 0x141, 0xf, 0xf, false));
    v += __int_as_float(__builtin_amdgcn_mov_dpp(__float_as_int(v), 0x140, 0xf, 0xf, false));
    v += __int_as_float(__builtin_amdgcn_update_dpp(0, __float_as_int(v), 0x142, 0xa, 0xf, false));
    v += __int_as_float(__builtin_amdgcn_update_dpp(0, __float_as_int(v), 0x143, 0xc, 0xf, false));
    return __int_as_float(__builtin_amdgcn_readlane(__float_as_int(v), 63));
}
DI float xrow4_sum(float s) {
    { auto r = __builtin_amdgcn_permlane32_swap(__float_as_uint(s), __float_as_uint(s), false, false); s = __uint_as_float(r[0]) + __uint_as_float(r[1]); }
    { auto r = __builtin_amdgcn_permlane16_swap(__float_as_uint(s), __float_as_uint(s), false, false); s = __uint_as_float(r[0]) + __uint_as_float(r[1]); }
    return s;
}
DI float silu_f(float v) { return v * frcp(1.0f + fexp(-v)); }
DI void unpack8(const u32x4 w, float* x) {
    x[0] = __uint_as_float(w.x << 16); x[1] = __uint_as_float(w.x & 0xffff0000u); x[2] = __uint_as_float(w.y << 16); x[3] = __uint_as_float(w.y & 0xffff0000u);
    x[4] = __uint_as_float(w.z << 16); x[5] = __uint_as_float(w.z & 0xffff0000u); x[6] = __uint_as_float(w.w << 16); x[7] = __uint_as_float(w.w & 0xffff0000u);
}
DI u32x4 pack8(const float* x) { u32x4 w; w.x = cvt_pk_bf16(x[0], x[1]); w.y = cvt_pk_bf16(x[2], x[3]); w.z = cvt_pk_bf16(x[4], x[5]); w.w = cvt_pk_bf16(x[6], x[7]); return w; }

constexpr int LD = 72;
DI void mm16x64(f32x4 (&acc)[4], const LAS bf16_t* Arow, const LAS bf16_t* B, int lane) {
    const int r = lane & 15, q = lane >> 4;
    bf16x8 a[2], b[2][4];
#pragma unroll
    for (int ks = 0; ks < 2; ++ks) { a[ks] = *(const LAS bf16x8*)(Arow + r * LD + ks * 32 + q * 8);
#pragma unroll
        for (int nt = 0; nt < 4; ++nt) b[ks][nt] = *(const LAS bf16x8*)(B + (nt * 16 + r) * LD + ks * 32 + q * 8); }
    __builtin_amdgcn_sched_barrier(0);
#pragma unroll
    for (int ks = 0; ks < 2; ++ks)
#pragma unroll
        for (int nt = 0; nt < 4; ++nt) acc[nt] = __builtin_amdgcn_mfma_f32_16x16x32_bf16(a[ks], b[ks][nt], acc[nt], 0, 0, 0);
    __builtin_amdgcn_sched_barrier(0);
}

DI void transpose_item(const float* W, int ld, int K, bf16_t* WT, int n0, int dst_row0, int k0, LAS float* scr, int lane) {
#pragma unroll 8
    for (int i = 0; i < 32; ++i) { const int kk = 2 * i + (lane >> 5); scr[kk * 33 + (lane & 31)] = W[(size_t)(k0 + kk) * ld + n0 + (lane & 31)]; }
    asm volatile("s_waitcnt lgkmcnt(0)" ::: "memory");
    const int c = lane & 7;
#pragma unroll
    for (int j = 0; j < 4; ++j) { const int n = (lane >> 3) + 8 * j; const LAS float* s = scr + (8 * c) * 33 + n;
        u32x4 o; o.x = cvt_pk_bf16(s[0 * 33], s[1 * 33]); o.y = cvt_pk_bf16(s[2 * 33], s[3 * 33]); o.z = cvt_pk_bf16(s[4 * 33], s[5 * 33]); o.w = cvt_pk_bf16(s[6 * 33], s[7 * 33]);
        *(u32x4*)(WT + (size_t)(dst_row0 + n) * K + k0 + 8 * c) = o; }
    asm volatile("s_waitcnt lgkmcnt(0)" ::: "memory");
}

DI void phase_prologue(const Params& p, LAS unsigned char* lds) {
    const int tid = opq_tid(), lane = tid & 63, wave = tid >> 6, G = opq_gdim();
    float* MOD = (float*)(p.ws + WS_MOD);
    LAS float* cs = (LAS float*)lds;
    LAS float* red = (LAS float*)(lds + 32768);
    for (int it = opq_bid(); it < 192; it += G) {
        const int l = it / 96, cgp = it % 96;
        __syncthreads();
        for (int i = tid; i < 8192; i += 512) { const float v = p.c[i]; cs[i] = v / (1.0f + expf(-v)); }
        __syncthreads();
        float acc[8];
#pragma unroll
        for (int b = 0; b < 8; ++b) acc[b] = 0.f;
        const float* wp = p.ada_w + (size_t)l * 1024 * 6144 + (size_t)(wave * 128) * 6144 + cgp * 64 + lane;
#pragma unroll 8
        for (int k = 0; k < 128; ++k) { const float wv = wp[(size_t)k * 6144];
#pragma unroll
            for (int b = 0; b < 8; ++b) acc[b] += cs[b * 1024 + wave * 128 + k] * wv; }
#pragma unroll
        for (int b = 0; b < 8; ++b) red[(wave * 8 + b) * 64 + lane] = acc[b];
        __syncthreads();
        { const int b = tid >> 6; float s = p.ada_b[l * 6144 + cgp * 64 + lane];
#pragma unroll
          for (int w = 0; w < 8; ++w) s += red[(w * 8 + b) * 64 + lane];
          MOD[(size_t)(l * 8 + b) * 6144 + cgp * 64 + lane] = s; }
    }
    __syncthreads();
    float* ROPE = (float*)(p.ws + WS_ROPE);
    for (int i = opq_bid() * 512 + tid; i < MT * 8; i += G * 512) {
        const int tok = i >> 3, f = i & 7;
        const float inv = powf(500000.0f, -(float)f * 0.125f);
        const float ang = (float)p.pos[tok] * inv;
        ROPE[tok * 16 + f] = cosf(ang); ROPE[tok * 16 + 8 + f] = sinf(ang);
    }
    LAS float* scr = (LAS float*)(lds + wave * 16384);
    const int gw = opq_bid() * 8 + wave, NGW = G * 8;
    for (int it = gw; it < 2 * 6144; it += NGW) {
        const int l = it / 6144; int r = it % 6144;
        bf16_t* WL = (bf16_t*)(p.ws + WS_W) + (size_t)l * W_LAYER;
        if (r < 1408) { const int kb = r / 88, nb = r % 88; transpose_item(p.w_in + (size_t)l * 1024 * DIN, DIN, 1024, WL + W_IN, 32 * nb, 32 * nb, 64 * kb, scr, lane); continue; } r -= 1408;
        if (r < 512) { const int kb = r / 32, nb = r % 32; transpose_item(p.w_out + (size_t)l * 1024 * 1024, 1024, 1024, WL + W_OUT, 32 * nb, 32 * nb, 64 * kb, scr, lane); continue; } r -= 512;
        if (r < 1408) { const int kb = r / 88, n0 = 32 * (r % 88); transpose_item(p.w_gate + (size_t)l * 1024 * DFF, DFF, 1024, WL + W_GU, n0, (n0 / 128) * 256 + (n0 % 128), 64 * kb, scr, lane); continue; } r -= 1408;
        if (r < 1408) { const int kb = r / 88, n0 = 32 * (r % 88); transpose_item(p.w_up + (size_t)l * 1024 * DFF, DFF, 1024, WL + W_GU, n0, (n0 / 128) * 256 + 128 + (n0 % 128), 64 * kb, scr, lane); continue; } r -= 1408;
        { const int kb = r / 32, nb = r % 32; transpose_item(p.w_down + (size_t)l * DFF * 1024, 1024, DFF, WL + W_DN, 32 * nb, 32 * nb, 64 * kb, scr, lane); }
    }
}

template <bool BGATE>
DI void phase_norm(const float* xin, const float* gain, const float* mod_l, int sh_off, int sc_off, bf16_t* H, const float* w_in_l, float* BGo) {
    const int tid = opq_tid(), lane = tid & 63, wave = tid >> 6;
    const int gw = opq_bid() * 8 + wave, NGW = opq_gdim() * 8;
    f32x4 w8[4][4][2];
    if (BGATE) {
#pragma unroll
        for (int j = 0; j < 4; ++j)
#pragma unroll
            for (int i = 0; i < 4; ++i) { const float* wp = w_in_l + (size_t)(4 * lane + 256 * j + i) * DIN + NP; w8[j][i][0] = *(const f32x4*)wp; w8[j][i][1] = *(const f32x4*)(wp + 4); }
    }
    for (int rg = gw; rg < MT / 16; rg += NGW) {
        const int row0 = rg * 16, b = row0 / SEQ;
        f32x4 A[4], S[4];
#pragma unroll
        for (int j = 0; j < 4; ++j) { const int k0 = 4 * lane + 256 * j;
            const f32x4 g = *(const f32x4*)(gain + k0), sc = *(const f32x4*)(mod_l + (size_t)b * 6144 + sc_off + k0);
            A[j] = g * (sc + 1.0f); S[j] = *(const f32x4*)(mod_l + (size_t)b * 6144 + sh_off + k0); }
        f32x4 nx[4];
#pragma unroll
        for (int j = 0; j < 4; ++j) nx[j] = *(const f32x4*)(xin + (size_t)row0 * DM + 4 * lane + 256 * j);
        for (int r = 0; r < 16; ++r) {
            f32x4 v[4]; float ss = 0.f;
#pragma unroll
            for (int j = 0; j < 4; ++j) { v[j] = nx[j]; ss += (v[j][0] * v[j][0] + v[j][1] * v[j][1]) + (v[j][2] * v[j][2] + v[j][3] * v[j][3]); }
            if (!BGATE) { const float* xr = xin + (size_t)(row0 + (r < 15 ? r + 1 : r)) * DM + 4 * lane;
#pragma unroll
              for (int j = 0; j < 4; ++j) nx[j] = *(const f32x4*)(xr + 256 * j); }
            ss = wave_sum(ss);
            const float rstd = rsqrtf(ss * (1.0f / DM) + EPS);
            bf16_t* hr = H + (size_t)(row0 + r) * DM + 4 * lane;
#pragma unroll
            for (int j = 0; j < 4; ++j) { v[j] = v[j] * rstd * A[j] + S[j]; u32x2 w; w.x = cvt_pk_bf16(v[j][0], v[j][1]); w.y = cvt_pk_bf16(v[j][2], v[j][3]); *(u32x2*)(hr + 256 * j) = w; }
            if (BGATE) {
                f32x4 s0 = {0.f, 0.f, 0.f, 0.f}, s1 = {0.f, 0.f, 0.f, 0.f};
#pragma unroll
                for (int j = 0; j < 4; ++j)
#pragma unroll
                    for (int i = 0; i < 4; ++i) { s0 += w8[j][i][0] * v[j][i]; s1 += w8[j][i][1] * v[j][i]; }
#pragma unroll
                for (int c = 0; c < 4; ++c) { s0[c] = wave_sum(s0[c]); s1[c] = wave_sum(s1[c]); }
                if (lane == 0) { *(f32x4*)(BGo + (size_t)(row0 + r) * 8) = s0; *(f32x4*)(BGo + (size_t)(row0 + r) * 8 + 4) = s1; }
                const float* xr = xin + (size_t)(row0 + (r < 15 ? r + 1 : r)) * DM + 4 * lane;
#pragma unroll
                for (int j = 0; j < 4; ++j) nx[j] = *(const f32x4*)(xr + 256 * j);
            }
        }
    }
}

DI void attn_item(const Params& p, int l, LAS unsigned char* lds, int item) {
    const int tid = opq_tid(), lane = tid & 63, w = tid >> 6;
    const bf16_t* PR = (const bf16_t*)(p.ws + WS_PROJ);
    bf16_t* MIX = (bf16_t*)(p.ws + WS_H);
    const float* ROPE = (const float*)(p.ws + WS_ROPE);
    const float* qn = p.qn + l * 64; const float* kn = p.kn + l * 64; const float* sinks = p.sinks + l * 8;
    LAS bf16_t* Ks = (LAS bf16_t*)lds;
    LAS bf16_t* Vt = (LAS bf16_t*)(lds + 36864);
    LAS bf16_t* Qs = (LAS bf16_t*)(lds + 70656);
    const int hkv = item & 1, qb = (item >> 1) & 31, b = item >> 6;
    const int qr = tid >> 2, qt = tid & 3, qtok = b * SEQ + qb * 128 + qr;
    const bf16_t* qp = PR + (size_t)qtok * NP + C_AQ + (hkv * 4) * 64 + qt * 16;
    u32x4 qw0 = *(const u32x4*)qp, qw1 = *(const u32x4*)(qp + 8);
    float rc[8], rs[8];
    if (qt == 0) {
#pragma unroll
        for (int i = 0; i < 8; ++i) { rc[i] = ROPE[(size_t)qtok * 16 + i]; rs[i] = ROPE[(size_t)qtok * 16 + 8 + i]; } }
    __syncthreads();
    {
        const int r = tid >> 1, half = tid & 1, kpos = qb * 128 - 128 + r;
        u32x4 kw[4], vw[4];
        if (kpos >= 0) { const bf16_t* rp = PR + (size_t)(b * SEQ + kpos) * NP + hkv * 64 + half * 32;
#pragma unroll
            for (int i = 0; i < 4; ++i) { kw[i] = *(const u32x4*)(rp + C_AK + 8 * i); vw[i] = *(const u32x4*)(rp + C_AV + 8 * i); } }
        else {
#pragma unroll
            for (int i = 0; i < 4; ++i) { kw[i] = (u32x4){0u, 0u, 0u, 0u}; vw[i] = (u32x4){0u, 0u, 0u, 0u}; } }
        float x[32];
#pragma unroll
        for (int i = 0; i < 4; ++i) unpack8(kw[i], x + 8 * i);
        float ss = 0.f;
#pragma unroll
        for (int i = 0; i < 32; ++i) ss += x[i] * x[i];
        ss += __shfl_xor(ss, 1);
        const float rstd = rsqrtf(ss * (1.0f / 64.0f) + EPS);
#pragma unroll
        for (int i = 0; i < 32; ++i) x[i] = x[i] * rstd * kn[half * 32 + i];
        if (half == 0 && kpos >= 0) { const float* rt = ROPE + (size_t)(b * SEQ + kpos) * 16;
#pragma unroll
            for (int i = 0; i < 8; ++i) { const float c = rt[i], s = rt[8 + i], x1 = x[i], x2 = x[i + 8]; x[i] = x1 * c - x2 * s; x[i + 8] = x2 * c + x1 * s; } }
#pragma unroll
        for (int i = 0; i < 4; ++i) *(LAS u32x4*)(Ks + r * 72 + half * 32 + 8 * i) = pack8(x + 8 * i);
#pragma unroll
        for (int i = 0; i < 4; ++i) { const unsigned ww[4] = {vw[i].x, vw[i].y, vw[i].z, vw[i].w};
#pragma unroll
            for (int e = 0; e < 4; ++e) { Vt[(half * 32 + 8 * i + 2 * e) * 264 + r] = (bf16_t)(ww[e] & 0xffffu); Vt[(half * 32 + 8 * i + 2 * e + 1) * 264 + r] = (bf16_t)(ww[e] >> 16); } }
    }
    const int q = lane & 15, quad = lane >> 4, qi = 16 * w + q;
    const int kt0 = w < 6 ? w : 6;
    for (int g = 0; g < 4; ++g) {
        const int hq = hkv * 4 + g;
        LDS_BARRIER();
        {
            float x[16]; unpack8(qw0, x); unpack8(qw1, x + 8);
            float ss = 0.f;
#pragma unroll
            for (int i = 0; i < 16; ++i) ss += x[i] * x[i];
            ss += __shfl_xor(ss, 1); ss += __shfl_xor(ss, 2);
            const float rstd = rsqrtf(ss * (1.0f / 64.0f) + EPS);
#pragma unroll
            for (int i = 0; i < 16; ++i) x[i] = x[i] * rstd * qn[qt * 16 + i];
            if (qt == 0) {
#pragma unroll
                for (int i = 0; i < 8; ++i) { const float x1 = x[i], x2 = x[i + 8]; x[i] = x1 * rc[i] - x2 * rs[i]; x[i + 8] = x2 * rc[i] + x1 * rs[i]; } }
#pragma unroll
            for (int i = 0; i < 16; ++i) x[i] *= 0.125f;
            *(LAS u32x4*)(Qs + qr * 72 + qt * 16) = pack8(x); *(LAS u32x4*)(Qs + qr * 72 + qt * 16 + 8) = pack8(x + 8);
        }
        if (g < 3) { qw0 = *(const u32x4*)(qp + (g + 1) * 64); qw1 = *(const u32x4*)(qp + (g + 1) * 64 + 8); }
        LDS_BARRIER();
        bf16x8 qf[2];
#pragma unroll
        for (int ks = 0; ks < 2; ++ks) qf[ks] = *(const LAS bf16x8*)(Qs + qi * 72 + ks * 32 + quad * 8);
        f32x4 st[10];
#pragma unroll
        for (int kt = 0; kt < 10; ++kt) {
            const LAS bf16_t* kr = Ks + (16 * (kt0 + kt) + q) * 72 + quad * 8;
            const bf16x8 k0 = *(const LAS bf16x8*)kr, k1 = *(const LAS bf16x8*)(kr + 32);
            f32x4 a = {0.f, 0.f, 0.f, 0.f};
            a = __builtin_amdgcn_mfma_f32_16x16x32_bf16(k0, qf[0], a, 0, 0, 0);
            a = __builtin_amdgcn_mfma_f32_16x16x32_bf16(k1, qf[1], a, 0, 0, 0);
            st[kt] = a;
        }
        const float sink = sinks[hq];
        float mx = sink;
#pragma unroll
        for (int kt = 0; kt < 10; ++kt)
#pragma unroll
            for (int j = 0; j < 4; ++j) { const int kj = 16 * (kt0 + kt) + quad * 4 + j, delta = qi + 128 - kj;
                const bool valid = (delta >= 0) && (delta < 128) && (qb * 128 + kj - 128 >= 0);
                const float s = valid ? st[kt][j] : -INFINITY; st[kt][j] = s; mx = fmaxf(mx, s); }
        mx = fmaxf(mx, __shfl_xor(mx, 16)); mx = fmaxf(mx, __shfl_xor(mx, 32));
        float sum = 0.f;
#pragma unroll
        for (int kt = 0; kt < 10; ++kt)
#pragma unroll
            for (int j = 0; j < 4; ++j) { const float pv = __expf(st[kt][j] - mx); st[kt][j] = pv; sum += pv; }
        sum += __shfl_xor(sum, 16); sum += __shfl_xor(sum, 32);
        sum += __expf(sink - mx);
        f32x4 ot[4];
#pragma unroll
        for (int dt = 0; dt < 4; ++dt) ot[dt] = (f32x4){0.f, 0.f, 0.f, 0.f};
#pragma unroll
        for (int kk = 0; kk < 5; ++kk) {
            u32x4 pw; pw.x = cvt_pk_bf16(st[2 * kk][0], st[2 * kk][1]); pw.y = cvt_pk_bf16(st[2 * kk][2], st[2 * kk][3]);
            pw.z = cvt_pk_bf16(st[2 * kk + 1][0], st[2 * kk + 1][1]); pw.w = cvt_pk_bf16(st[2 * kk + 1][2], st[2 * kk + 1][3]);
            const bf16x8 pf = __builtin_bit_cast(bf16x8, pw);
#pragma unroll
            for (int dt = 0; dt < 4; ++dt) {
                const LAS bf16_t* vr = Vt + (16 * dt + q) * 264 + 16 * kt0 + 32 * kk + quad * 4;
                const s16x4 lo = *(const LAS s16x4*)vr, hi = *(const LAS s16x4*)(vr + 16);
                const bf16x8 vf = __builtin_shufflevector(lo, hi, 0, 1, 2, 3, 4, 5, 6, 7);
                ot[dt] = __builtin_amdgcn_mfma_f32_16x16x32_bf16(vf, pf, ot[dt], 0, 0, 0);
            }
        }
        const float inv = 1.0f / sum;
        bf16_t* op = MIX + (size_t)(b * SEQ + qb * 128 + qi) * 1024 + hq * 64 + quad * 4;
#pragma unroll
        for (int dt = 0; dt < 4; ++dt) { u32x2 wv; wv.x = cvt_pk_bf16(ot[dt][0] * inv, ot[dt][1] * inv); wv.y = cvt_pk_bf16(ot[dt][2] * inv, ot[dt][3] * inv); *(u32x2*)(op + 16 * dt) = wv; }
    }
}

DI void hgrn_cum(const bf16_t* zp, float lbv, LAS float* tot, int d, int part, float (&cum)[16], float (&kg)[16], float& cmid, float& clast) {
    float run = 0.f, zz[16];
#pragma unroll
    for (int i = 0; i < 16; ++i) zz[i] = bf2f(zp[(size_t)i * NP]);
    if (lbv == 0.f) {
#pragma unroll
        for (int i = 0; i < 16; ++i) {
            const float z = zz[i], e = fexp(-fabsf(z)), inv = frcp(1.0f + e), sn = e * inv;
            kg[i] = z >= 0.f ? sn : inv;
            run += fminf(z, 0.f) - __logf(1.0f + e); cum[i] = run;
        }
    } else {
#pragma unroll
        for (int i = 0; i < 16; ++i) {
            const float z = zz[i], e = fexp(-fabsf(z)), inv = frcp(1.0f + e), sn = e * inv;
            const float sig = z >= 0.f ? inv : sn, oms = z >= 0.f ? sn : inv;
            kg[i] = (1.0f - lbv) * oms;
            run += __logf(lbv + (1.0f - lbv) * sig); cum[i] = run;
        }
    }
    tot[part * 64 + d] = run;
    __syncthreads();
    const float t0 = tot[d], t1 = tot[64 + d], t2 = tot[128 + d], t3 = tot[192 + d];
    const float off = part == 0 ? 0.f : (part == 1 ? t0 : (part == 2 ? t0 + t1 : t0 + t1 + t2));
#pragma unroll
    for (int i = 0; i < 16; ++i) cum[i] += off;
    cmid = t0 + t1; clast = (t0 + t1) + (t2 + t3);
}
DI float hgrn_lb(const Params& p, int l, int idx) {
    if (l == 0) return 0.f;
    const float a0 = p.lb_logits[idx], a1 = p.lb_logits[256 + idx];
    return 1.0f / (1.0f + expf(a0 - a1));
}

DI void phase_hgrn_local(const Params& p, int l, LAS unsigned char* lds) {
    const int tid = opq_tid(), lane = tid & 63, grp = tid >> 8, lt = tid & 255, d = lt & 63, part = lt >> 6, quad = lane >> 4;
    const bf16_t* PR = (const bf16_t*)(p.ws + WS_PROJ);
    float* BST = (float*)(p.ws + WS_BST); float* BDEC = (float*)(p.ws + WS_BDEC);
    LAS unsigned char* gl = lds + grp * 65536;
    LAS bf16_t* kdT = (LAS bf16_t*)gl; LAS bf16_t* Vt = kdT + 64 * LD; LAS float* tot = (LAS float*)(gl + 2 * 64 * LD * 2);
    for (int pr = opq_bid(); pr < NUNIT / 2; pr += opq_gdim()) {
        const int u = pr * 2 + grp, h = u & 3, n = (u >> 2) & 63, b = u >> 8;
        const size_t row0 = (size_t)b * SEQ + n * 64 + part * 16;
        const float lbv = hgrn_lb(p, l, 64 * h + d);
        __syncthreads();
        float cum[16], kg[16], cmid, clast;
        hgrn_cum(PR + row0 * NP + C_BF + 64 * h + d, lbv, tot, d, part, cum, kg, cmid, clast);
        float t[16];
#pragma unroll
        for (int i = 0; i < 16; ++i) t[i] = kg[i] * fexp(clast - cum[i]);
        *(LAS u32x4*)(kdT + d * LD + 16 * part) = pack8(t); *(LAS u32x4*)(kdT + d * LD + 16 * part + 8) = pack8(t + 8);
#pragma unroll
        for (int i = 0; i < 16; ++i) t[i] = bf2f(PR[(row0 + i) * NP + C_BV + 64 * h + d]);
        *(LAS u32x4*)(Vt + d * LD + 16 * part) = pack8(t); *(LAS u32x4*)(Vt + d * LD + 16 * part + 8) = pack8(t + 8);
        if (part == 0) BDEC[(size_t)u * 64 + d] = expf(clast);
        __syncthreads();
        f32x4 acc[4];
#pragma unroll
        for (int nt = 0; nt < 4; ++nt) acc[nt] = (f32x4){0.f, 0.f, 0.f, 0.f};
        mm16x64(acc, kdT + 16 * part * LD, Vt, lane);
        float* Bo = BST + (size_t)u * 4096;
#pragma unroll
        for (int nt = 0; nt < 4; ++nt)
#pragma unroll
            for (int j = 0; j < 4; ++j) Bo[(16 * part + quad * 4 + j) * 64 + 16 * nt + (lane & 15)] = acc[nt][j];
    }
}

DI void phase_hgrn_scan(const Params& p) {
    const float* BST = (const float*)(p.ws + WS_BST); float* BS2 = (float*)(p.ws + WS_BST2); const float* BDEC = (const float*)(p.ws + WS_BDEC);
    for (int idx = opq_bid() * 512 + opq_tid(); idx < 32 * 4096; idx += opq_gdim() * 512) {
        const int chain = idx >> 12, de = idx & 4095, b = chain >> 2, h = chain & 3;
        const size_t o0 = ((size_t)(b * 64) * 4 + h) * 4096 + de; const float* dp = BDEC + ((size_t)(b * 64) * 4 + h) * 64 + (de >> 6);
        float S = 0.f;
#pragma unroll
        for (int n0 = 0; n0 < 64; n0 += 32) {
            float bn[32], dc[32];
#pragma unroll
            for (int i = 0; i < 32; ++i) { bn[i] = BST[o0 + (size_t)(n0 + i) * 4 * 4096]; dc[i] = dp[(size_t)(n0 + i) * 4 * 64]; }
            __builtin_amdgcn_sched_barrier(0);
#pragma unroll
            for (int i = 0; i < 32; ++i) { BS2[o0 + (size_t)(n0 + i) * 4 * 4096] = S; S = dc[i] * S + bn[i]; }
        }
    }
}

DI void phase_hgrn_out(const Params& p, int l, LAS unsigned char* lds, int wg, int nwg) {
    const int tid = opq_tid(), lane = tid & 63, grp = tid >> 8, lt = tid & 255, d = lt & 63, part = lt >> 6, quad = lane >> 4;
    const bf16_t* PR = (const bf16_t*)(p.ws + WS_PROJ);
    bf16_t* MIX = (bf16_t*)(p.ws + WS_H);
    const float* BST = (const float*)(p.ws + WS_BST2);
    const float* hn = p.hgrn_norm + l * 64;
    LAS unsigned char* gl = lds + grp * 65536;
    LAS bf16_t* qs = (LAS bf16_t*)gl; LAS bf16_t* ks = qs + 64 * LD; LAS bf16_t* qcs = ks + 64 * LD; LAS bf16_t* Vt = qcs + 64 * LD; LAS bf16_t* St = Vt + 64 * LD; LAS bf16_t* at = St + 64 * LD;
    LAS float* tot = (LAS float*)(gl + 6 * 64 * LD * 2);
    for (int pr = wg; pr < NUNIT / 2; pr += nwg) {
        const int u = pr * 2 + grp, h = u & 3, n = (u >> 2) & 63, b = u >> 8;
        const size_t row0 = (size_t)b * SEQ + n * 64 + part * 16;
        const float lbv = hgrn_lb(p, l, 64 * h + d);
        __syncthreads();
        float qin[16], vin[16], sin_[16], gin[4][4];
#pragma unroll
        for (int i = 0; i < 16; ++i) { qin[i] = bf2f(PR[(row0 + i) * NP + C_BQ + 64 * h + d]); vin[i] = bf2f(PR[(row0 + i) * NP + C_BV + 64 * h + d]); sin_[i] = BST[(size_t)u * 4096 + (16 * part + i) * 64 + d]; }
#pragma unroll
        for (int j = 0; j < 4; ++j)
#pragma unroll
            for (int nt = 0; nt < 4; ++nt) gin[j][nt] = bf2f(PR[(row0 + quad * 4 + j) * NP + C_BG + 64 * h + 16 * nt + (lane & 15)]);
        float cum[16], kg[16], cmid, clast;
        hgrn_cum(PR + row0 * NP + C_BF + 64 * h + d, lbv, tot, d, part, cum, kg, cmid, clast);
#pragma unroll
        for (int i = 0; i < 16; ++i) { const int t = 16 * part + i; const float qv = qin[i];
            qs[t * LD + d] = f2bf(qv * fexp(cum[i] - cmid)); ks[t * LD + d] = f2bf(kg[i] * fexp(cmid - cum[i])); qcs[t * LD + d] = f2bf(qv * fexp(cum[i])); }
        *(LAS u32x4*)(Vt + d * LD + 16 * part) = pack8(vin); *(LAS u32x4*)(Vt + d * LD + 16 * part + 8) = pack8(vin + 8);
        *(LAS u32x4*)(St + d * LD + 16 * part) = pack8(sin_); *(LAS u32x4*)(St + d * LD + 16 * part + 8) = pack8(sin_ + 8);
        __syncthreads();
        f32x4 acc[4];
#pragma unroll
        for (int nt = 0; nt < 4; ++nt) acc[nt] = (f32x4){0.f, 0.f, 0.f, 0.f};
        mm16x64(acc, qs + 16 * part * LD, ks, lane);
#pragma unroll
        for (int nt = 0; nt < 4; ++nt)
#pragma unroll
            for (int j = 0; j < 4; ++j) { const int t = 16 * part + quad * 4 + j, s = 16 * nt + (lane & 15); at[t * LD + s] = f2bf(s <= t ? acc[nt][j] : 0.f); }
        __syncthreads();
        f32x4 o[4];
#pragma unroll
        for (int nt = 0; nt < 4; ++nt) o[nt] = (f32x4){0.f, 0.f, 0.f, 0.f};
        mm16x64(o, at + 16 * part * LD, Vt, lane);
        mm16x64(o, qcs + 16 * part * LD, St, lane);
#pragma unroll
        for (int j = 0; j < 4; ++j) {
            float ss = o[0][j] * o[0][j] + o[1][j] * o[1][j] + o[2][j] * o[2][j] + o[3][j] * o[3][j];
            ss += __shfl_xor(ss, 1); ss += __shfl_xor(ss, 2); ss += __shfl_xor(ss, 4); ss += __shfl_xor(ss, 8);
            const float rstd = rsqrtf(ss * (1.0f / 64.0f) + EPS);
            const size_t row = (size_t)b * SEQ + n * 64 + 16 * part + quad * 4 + j;
#pragma unroll
            for (int nt = 0; nt < 4; ++nt) { const int e = 16 * nt + (lane & 15);
                MIX[row * 1024 + 512 + 64 * h + e] = f2bf(o[nt][j] * rstd * hn[e] * silu_f(gin[j][nt])); }
        }
    }
}

DI void phase_gdn_local(const Params& p, int l, LAS unsigned char* lds) {
    const int tid = opq_tid(), lane = tid & 63, grp = tid >> 8, lt = tid & 255, d = lt & 63, part = lt >> 6, quad = lane >> 4;
    const bf16_t* PR = (const bf16_t*)(p.ws + WS_PROJ);
    const float* BG = (const float*)(p.ws + WS_BGATE);
    float* CGL = (float*)(p.ws + WS_CGL); bf16_t* CUt = (bf16_t*)(p.ws + WS_CU); bf16_t* CWb = (bf16_t*)(p.ws + WS_CW);
    bf16_t* CKD = (bf16_t*)(p.ws + WS_CKD); bf16_t* CQD = (bf16_t*)(p.ws + WS_CQD); bf16_t* CQK = (bf16_t*)(p.ws + WS_CQK);
    const float* convw = p.conv_w + (size_t)l * 4 * 768;
    LAS unsigned char* gl = lds + grp * 65536;
    LAS float* kf = (LAS float*)gl;
    LAS float* vf = (LAS float*)(gl + 16640);
    LAS bf16_t* qb = (LAS bf16_t*)(gl + 33280);
    LAS bf16_t* kb = qb + 64 * LD;
    LAS float* Am = (LAS float*)(gl + 33280);
    LAS float* Gs = (LAS float*)(gl + 51712);
    LAS float* betas = Gs + 64;
    for (int pr = opq_bid(); pr < NUNIT / 2; pr += opq_gdim()) {
        const int u = pr * 2 + grp, h = u & 3, n = (u >> 2) & 63, b = u >> 8;
        const size_t rowu = (size_t)b * SEQ + n * 64;
        __syncthreads();
        float bb = 0.f, aa = 0.f;
        if (lt < 64) { bb = BG[(rowu + lt) * 8 + h]; aa = BG[(rowu + lt) * 8 + 4 + h]; }
        float cwt[3][4], xin[3][19];
#pragma unroll
        for (int ten = 0; ten < 3; ++ten) {
            const int col = (ten == 0 ? C_CQ : (ten == 1 ? C_CK : C_CV)) + 64 * h + d, ch = ten * 256 + 64 * h + d;
#pragma unroll
            for (int j = 0; j < 4; ++j) cwt[ten][j] = convw[j * 768 + ch];
#pragma unroll
            for (int i = 0; i < 19; ++i) { const int tt = n * 64 + 16 * part + i - 3;
                const float xv = bf2f(PR[((size_t)b * SEQ + (tt > 0 ? tt : 0)) * NP + col]); xin[ten][i] = tt >= 0 ? xv : 0.f; }
        }
        if (lt < 64) {
            const float beta = 1.0f / (1.0f + expf(-bb));
            const float xg = aa + p.dt_bias[l * 4 + h];
            const float sp = fmaxf(xg, 0.f) + log1pf(expf(-fabsf(xg)));
            float g = -expf(p.a_log[l * 4 + h]) * sp;
#pragma unroll
            for (int o = 1; o < 64; o <<= 1) { const float v = __shfl_up(g, o); if (lane >= o) g += v; }
            Gs[lt] = g; betas[lt] = beta;
            if (lt == 63) CGL[u] = expf(g);
        }
        float yq[16], yk[16], sq[16], sk[16];
#pragma unroll
        for (int i = 0; i < 16; ++i) {
            yq[i] = silu_f(cwt[0][0] * xin[0][i] + cwt[0][1] * xin[0][i + 1] + cwt[0][2] * xin[0][i + 2] + cwt[0][3] * xin[0][i + 3]);
            yk[i] = silu_f(cwt[1][0] * xin[1][i] + cwt[1][1] * xin[1][i + 1] + cwt[1][2] * xin[1][i + 2] + cwt[1][3] * xin[1][i + 3]);
            const float yv = silu_f(cwt[2][0] * xin[2][i] + cwt[2][1] * xin[2][i + 1] + cwt[2][2] * xin[2][i + 2] + cwt[2][3] * xin[2][i + 3]);
            vf[(16 * part + i) * 65 + d] = yv;
            sq[i] = yq[i] * yq[i]; sk[i] = yk[i] * yk[i];
        }
#pragma unroll
        for (int i = 0; i < 16; ++i) { sq[i] = wave_sum_dpp(sq[i]); sk[i] = wave_sum_dpp(sk[i]); }
        __syncthreads();
        const float Glast = Gs[63];
        float kdv[16];
#pragma unroll
        for (int i = 0; i < 16; ++i) {
            const int t = 16 * part + i; const float Gt = Gs[t];
            const float qv = yq[i] * rsqrtf(sq[i] + EPS) * 0.125f, nv = yk[i] * rsqrtf(sk[i] + EPS);
            qb[t * LD + d] = f2bf(qv); CQD[(size_t)u * 4096 + t * 64 + d] = f2bf(qv * fexp(Gt));
            kf[t * 65 + d] = nv; kb[t * LD + d] = f2bf(nv); kdv[i] = nv * fexp(Glast - Gt);
        }
        { bf16_t* kp = CKD + (size_t)u * 4096 + d * 64 + 16 * part; *(u32x4*)kp = pack8(kdv); *(u32x4*)(kp + 8) = pack8(kdv + 8); }
        __syncthreads();
        f32x4 kk[4], qk[4];
#pragma unroll
        for (int nt = 0; nt < 4; ++nt) { kk[nt] = (f32x4){0.f, 0.f, 0.f, 0.f}; qk[nt] = (f32x4){0.f, 0.f, 0.f, 0.f}; }
        mm16x64(kk, kb + 16 * part * LD, kb, lane);
        mm16x64(qk, qb + 16 * part * LD, kb, lane);
        __syncthreads();
        {
            float gt[4], bt[4], gs[4];
#pragma unroll
            for (int j = 0; j < 4; ++j) { gt[j] = Gs[16 * part + quad * 4 + j]; bt[j] = betas[16 * part + quad * 4 + j]; gs[j] = Gs[16 * j + (lane & 15)]; }
#pragma unroll
            for (int nt = 0; nt < 4; ++nt)
#pragma unroll
                for (int j = 0; j < 4; ++j) { const int t = 16 * part + quad * 4 + j, s = 16 * nt + (lane & 15);
                    const float ex = fexp(fminf(gt[j] - gs[nt], 0.f));
                    const float L = s <= t ? ex : 0.f;
                    CQK[(size_t)u * 4096 + t * 64 + s] = f2bf(qk[nt][j] * L);
                    Am[t * 68 + s] = s < t ? bt[j] * kk[nt][j] * L : 0.f; }
        }
        __syncthreads();
        if (lt < 128) {
            const int c = lt & 63; const bool isw = lt >= 64;
            float xs[64];
            if (isw) {
#pragma unroll
                for (int i = 0; i < 64; ++i) { xs[i] = kf[i * 65 + c] * betas[i] * fexp(Gs[i]); if ((i & 15) == 15) __builtin_amdgcn_sched_barrier(0); }
            } else {
#pragma unroll
                for (int i = 0; i < 64; ++i) { xs[i] = vf[i * 65 + c] * betas[i]; if ((i & 15) == 15) __builtin_amdgcn_sched_barrier(0); }
            }
#pragma unroll
            for (int i = 1; i < 64; ++i) {
                f32x4 cur[16];
#pragma unroll
                for (int j4 = 0; j4 < (i + 3) / 4; ++j4) cur[j4] = *(const LAS f32x4*)(Am + i * 68 + 4 * j4);
                __builtin_amdgcn_sched_barrier(0);
                float pa[4] = {0.f, 0.f, 0.f, 0.f};
#pragma unroll
                for (int j4 = 0; j4 < (i + 3) / 4; ++j4)
#pragma unroll
                    for (int e = 0; e < 4; ++e) if (4 * j4 + e < i) pa[e] += cur[j4][e] * xs[4 * j4 + e];
                xs[i] -= (pa[0] + pa[1]) + (pa[2] + pa[3]);
                __builtin_amdgcn_sched_barrier(0);
            }
            if (isw) { bf16_t* dstW = CWb + (size_t)u * 4096 + c;
#pragma unroll
                for (int i = 0; i < 64; ++i) dstW[i * 64] = f2bf(xs[i]); }
            else { bf16_t* up = CUt + (size_t)u * 4096 + c * 64;
#pragma unroll
                for (int i8 = 0; i8 < 8; ++i8) *(u32x4*)(up + 8 * i8) = pack8(xs + 8 * i8); }
        } else {
            const int half = (lt >> 6) - 2; const float gnd = p.gdn_norm[l * 64 + d];
            float gin[32];
#pragma unroll
            for (int i = 0; i < 32; ++i) gin[i] = bf2f(PR[(rowu + 32 * half + i) * NP + C_CG + 64 * h + d]);
#pragma unroll
            for (int i = 0; i < 32; ++i) gin[i] = silu_f(gin[i]) * gnd;
            bf16_t* gp = (bf16_t*)(p.ws + WS_CO) + (size_t)u * 4096 + (32 * half) * 64 + d;
#pragma unroll
            for (int i = 0; i < 32; ++i) gp[i * 64] = f2bf(gin[i]);
        }
    }
}

DI void mm64x16_t(f32x4 (&acc)[4], const LAS bf16_t* E, const LAS bf16_t* Trow, int lane) {
    const int r = lane & 15, q = lane >> 4;
    bf16x8 b[2], a[2][4];
#pragma unroll
    for (int ks = 0; ks < 2; ++ks) { b[ks] = *(const LAS bf16x8*)(Trow + r * LD + ks * 32 + q * 8);
#pragma unroll
        for (int et = 0; et < 4; ++et) a[ks][et] = *(const LAS bf16x8*)(E + (et * 16 + r) * LD + ks * 32 + q * 8); }
    __builtin_amdgcn_sched_barrier(0);
#pragma unroll
    for (int ks = 0; ks < 2; ++ks)
#pragma unroll
        for (int et = 0; et < 4; ++et) acc[et] = __builtin_amdgcn_mfma_f32_16x16x32_bf16(a[ks][et], b[ks], acc[et], 0, 0, 0);
    __builtin_amdgcn_sched_barrier(0);
}
struct ScanRegs { u32x4 w, kd, qd, qk, ut, gt; };
constexpr int TILE_E = 64 * LD;
DI void scan_issue(ScanRegs& r, const Params& p, int b, int h, int m, int tid) {
    const size_t u = (size_t)(b * 64 + (m < 64 ? m : 63)) * 4 + h;
    r.w = *(const u32x4*)((const bf16_t*)(p.ws + WS_CW) + u * 4096 + tid * 8); r.kd = *(const u32x4*)((const bf16_t*)(p.ws + WS_CKD) + u * 4096 + tid * 8);
    r.qd = *(const u32x4*)((const bf16_t*)(p.ws + WS_CQD) + u * 4096 + tid * 8); r.qk = *(const u32x4*)((const bf16_t*)(p.ws + WS_CQK) + u * 4096 + tid * 8);
    r.ut = *(const u32x4*)((const bf16_t*)(p.ws + WS_CU) + u * 4096 + tid * 8);
    r.gt = *(const u32x4*)((const bf16_t*)(p.ws + WS_CO) + u * 4096 + tid * 8);
}
DI void scan_store(const ScanRegs& r, LAS bf16_t* buf, int tid) {
    const int off = (tid >> 3) * LD + (tid & 7) * 8;
    *(LAS u32x4*)(buf + off) = r.w; *(LAS u32x4*)(buf + TILE_E + off) = r.kd; *(LAS u32x4*)(buf + 2 * TILE_E + off) = r.qd; *(LAS u32x4*)(buf + 3 * TILE_E + off) = r.qk;
    *(LAS u32x4*)(buf + 4 * TILE_E + off) = r.ut; *(LAS u32x4*)(buf + 5 * TILE_E + off) = r.gt;
}
DI void gdn_scan_chain(const Params& p, int l, LAS unsigned char* lds, int chain) {
    const int tid = opq_tid(), lane = tid & 63, w = tid >> 6, quad = lane >> 4, r16 = lane & 15, mt = w & 3;
    bf16_t* MIX = (bf16_t*)(p.ws + WS_H);
    LAS bf16_t* buf0 = (LAS bf16_t*)lds; LAS bf16_t* buf1 = buf0 + 6 * TILE_E; LAS bf16_t* St = buf1 + 6 * TILE_E; LAS bf16_t* VNt = St + TILE_E;
    const int b = chain >> 2, h = chain & 3, urow = 16 * mt + quad * 4;
    f32x4 SG[4];
#pragma unroll
    for (int nt = 0; nt < 4; ++nt) SG[nt] = (f32x4){0.f, 0.f, 0.f, 0.f};
    ScanRegs R0, R1, R2, R3;
    scan_issue(R0, p, b, h, 0, tid); scan_issue(R1, p, b, h, 1, tid); scan_issue(R2, p, b, h, 2, tid); scan_issue(R3, p, b, h, 3, tid);
    LAS float* GLs = (LAS float*)(VNt + TILE_E);
    LAS bf16_t* Os = VNt + TILE_E + 128;
    bf16_t* mixp = MIX + ((size_t)b * SEQ + (tid >> 3)) * 1024 + 768 + 64 * h + (tid & 7) * 8;
    __syncthreads();
    scan_store(R0, buf0, tid);
    if (tid < 64) GLs[tid] = ((const float*)(p.ws + WS_CGL))[(size_t)(b * 64 + tid) * 4 + h];
    if (w < 4) {
#pragma unroll
        for (int nt = 0; nt < 4; ++nt) *(LAS u32x2*)(St + (16 * nt + r16) * LD + urow) = (u32x2){0u, 0u};
    }
    __syncthreads();
#define GDN_STEP(k, RC, RN, BC, BN) do { const int m = n + (k); \
        *(u32x4*)(mixp + (size_t)(m > 0 ? m - 1 : 0) * 64 * 1024) = *(const LAS u32x4*)(Os + (tid >> 3) * LD + (tid & 7) * 8); \
        scan_issue(RC, p, b, h, m + 4, tid); \
        f32x4 AC[4]; _Pragma("unroll") for (int nt = 0; nt < 4; ++nt) AC[nt] = (f32x4){0.f, 0.f, 0.f, 0.f}; \
        if (w < 4) { u32x2 uwv[4]; _Pragma("unroll") for (int nt = 0; nt < 4; ++nt) uwv[nt] = *(const LAS u32x2*)(BC + 4 * TILE_E + (16 * nt + r16) * LD + urow); \
            mm16x64(AC, BC + 16 * mt * LD, St, lane); \
            _Pragma("unroll") for (int nt = 0; nt < 4; ++nt) { float uu[4]; { const u32x2 uw = uwv[nt]; \
                    uu[0] = __uint_as_float(uw.x << 16); uu[1] = __uint_as_float(uw.x & 0xffff0000u); uu[2] = __uint_as_float(uw.y << 16); uu[3] = __uint_as_float(uw.y & 0xffff0000u); } \
                u32x2 pv; pv.x = cvt_pk_bf16(uu[0] - AC[nt][0], uu[1] - AC[nt][1]); pv.y = cvt_pk_bf16(uu[2] - AC[nt][2], uu[3] - AC[nt][3]); *(LAS u32x2*)(VNt + (16 * nt + r16) * LD + urow) = pv; \
                AC[nt] = (f32x4){0.f, 0.f, 0.f, 0.f}; } } \
        else { mm64x16_t(AC, St, BC + 2 * TILE_E + 16 * mt * LD, lane); scan_store(RN, BN, tid); } \
        LDS_BARRIER(); \
        if (w < 4) { const float gl = GLs[m]; mm16x64(AC, BC + TILE_E + 16 * mt * LD, VNt, lane); \
            _Pragma("unroll") for (int nt = 0; nt < 4; ++nt) { SG[nt] = SG[nt] * gl + AC[nt]; \
                u32x2 pv; pv.x = cvt_pk_bf16(SG[nt][0], SG[nt][1]); pv.y = cvt_pk_bf16(SG[nt][2], SG[nt][3]); *(LAS u32x2*)(St + (16 * nt + r16) * LD + urow) = pv; } scan_store(RN, BN, tid); } \
        else { u32x2 gwv[4]; _Pragma("unroll") for (int et = 0; et < 4; ++et) gwv[et] = *(const LAS u32x2*)(BC + 5 * TILE_E + (16 * mt + r16) * LD + 16 * et + 4 * quad); \
            mm64x16_t(AC, VNt, BC + 3 * TILE_E + 16 * mt * LD, lane);        \
            float ss = 0.f; \
            _Pragma("unroll") for (int et = 0; et < 4; ++et) ss += (AC[et][0] * AC[et][0] + AC[et][1] * AC[et][1]) + (AC[et][2] * AC[et][2] + AC[et][3] * AC[et][3]); \
            ss = xrow4_sum(ss); \
            const float rstd = rsqrtf(ss * (1.0f / 64.0f) + EPS); \
            _Pragma("unroll") for (int et = 0; et < 4; ++et) { const u32x2 gw = gwv[et]; \
                u32x2 ov; ov.x = cvt_pk_bf16(AC[et][0] * rstd * __uint_as_float(gw.x << 16), AC[et][1] * rstd * __uint_as_float(gw.x & 0xffff0000u)); \
                ov.y = cvt_pk_bf16(AC[et][2] * rstd * __uint_as_float(gw.y << 16), AC[et][3] * rstd * __uint_as_float(gw.y & 0xffff0000u)); \
                *(LAS u32x2*)(Os + (16 * mt + r16) * LD + 16 * et + 4 * quad) = ov; } } \
        LDS_BARRIER(); } while (0)
    for (int n = 0; n < 64; n += 4) {
        GDN_STEP(0, R0, R1, buf0, buf1); GDN_STEP(1, R1, R2, buf1, buf0); GDN_STEP(2, R2, R3, buf0, buf1); GDN_STEP(3, R3, R0, buf1, buf0);
    }
    *(u32x4*)(mixp + (size_t)63 * 64 * 1024) = *(const LAS u32x4*)(Os + (tid >> 3) * LD + (tid & 7) * 8);
#undef GDN_STEP
}

DI void phase_gdn_norm(const Params& p, int l) {
    const int tid = opq_tid(), lane = tid & 63, wave = tid >> 6;
    const bf16_t* PR = (const bf16_t*)(p.ws + WS_PROJ);
    bf16_t* MIX = (bf16_t*)(p.ws + WS_H);
    const float* CO = (const float*)(p.ws + WS_CO);
    const float gn = p.gdn_norm[l * 64 + lane];
    for (int row = opq_bid() * 8 + wave; row < MT; row += opq_gdim() * 8) {
        float v[4], g[4];
#pragma unroll
        for (int h = 0; h < 4; ++h) { v[h] = CO[(size_t)row * 256 + 64 * h + lane]; g[h] = bf2f(PR[(size_t)row * NP + C_CG + 64 * h + lane]); }
#pragma unroll
        for (int h = 0; h < 4; ++h) { const float ss = wave_sum(v[h] * v[h]);
            MIX[(size_t)row * 1024 + 768 + 64 * h + lane] = f2bf(v[h] * rsqrtf(ss * (1.0f / 64.0f) + EPS) * gn * silu_f(g[h])); }
    }
}

#define XB_TMO      128
#define XB_XCNT(j)  (256  + 64 * (j))
#define XB_XSUB(j)  (1280 + 64 * (j))
#define XB_XGEN(j)  (2304 + 64 * (j))
#define XB_TOP      3328
#define XB_TOPGEN   3392
#define XCD_BAR_WORDS 3456
#define XB_SPIN_CAP (1u << 18)

__device__ __forceinline__ unsigned xb_ld(unsigned* p)              { return __hip_atomic_load(p, __ATOMIC_RELAXED, __HIP_MEMORY_SCOPE_AGENT); }
__device__ __forceinline__ unsigned xb_add(unsigned* p, unsigned v) { return __hip_atomic_fetch_add(p, v, __ATOMIC_RELAXED, __HIP_MEMORY_SCOPE_AGENT); }
__device__ __forceinline__ unsigned xb_xcc_id() { return (unsigned)__builtin_amdgcn_s_getreg((3 << 11) | 20) & 0xFu; }
#define XB_SPIN(cond, bar) do { unsigned _sp = 0; while (cond) { __builtin_amdgcn_s_sleep(1); \
    if ((++_sp & 255u) == 0u) { if (xb_ld(&(bar)[XB_TMO])) break; if (_sp > XB_SPIN_CAP) { atomicAdd(&(bar)[XB_TMO], 1u); break; } } } } while (0)

struct XcdBarrier {
    unsigned* bar; unsigned x;
    volatile LAS unsigned* st;
};

__device__ __forceinline__ XcdBarrier xcd_barrier_post(unsigned* bar, volatile LAS unsigned* st) {
    XcdBarrier b; b.bar = bar; b.x = xb_xcc_id(); b.st = st;
    if (threadIdx.x == 0) (void)xb_add(&bar[XB_XCNT(b.x)], 1u);
    return b;
}
__device__ __forceinline__ void xcd_barrier_complete(unsigned* bar, unsigned x, unsigned& nloc, unsigned& nx) {
    const unsigned G = gridDim.x * gridDim.y * gridDim.z;
    unsigned sum, cnt, mine, sp = 0u;
    for (;;) {
        sum = 0u; cnt = 0u; mine = 0u;
#pragma unroll
        for (unsigned j = 0; j < 16; ++j) { const unsigned c = xb_ld(&bar[XB_XCNT(j)]); sum += c; cnt += (c > 0u) ? 1u : 0u; mine = (j == x) ? c : mine; }
        if (sum == G) break;
        __builtin_amdgcn_s_sleep(1);
        if ((++sp & 255u) == 0u) { if (xb_ld(&bar[XB_TMO])) break; if (sp > XB_SPIN_CAP) { atomicAdd(&bar[XB_TMO], 1u); break; } }
    }
    nloc = mine > 0u ? mine : 1u; nx = cnt > 0u ? cnt : 1u;
}

__device__ __forceinline__ void xcd_barrier(const XcdBarrier& b) {
    asm volatile("s_waitcnt vmcnt(0)" ::: "memory");
    __syncthreads();
    if (threadIdx.x == 0) {
        unsigned* bar = b.bar;
        __builtin_amdgcn_s_waitcnt(0);
        unsigned nloc = b.st[0], nx = b.st[1];
        if (nloc == 0u) { xcd_barrier_complete(bar, b.x, nloc, nx); b.st[0] = nloc; b.st[1] = nx; }
        const unsigned old = xb_add(&bar[XB_XSUB(b.x)], 1u);
        const unsigned gen = old / nloc;
        if (old + 1u == (gen + 1u) * nloc) {
            __builtin_amdgcn_fence(__ATOMIC_RELEASE, "agent");
            asm volatile("s_waitcnt vmcnt(0)" ::: "memory");
            const unsigned og = xb_add(&bar[XB_TOP], 1u);
            const unsigned tg = og / nx;
            if (og + 1u == (tg + 1u) * nx) xb_add(&bar[XB_TOPGEN], 1u);
            else XB_SPIN(xb_ld(&bar[XB_TOPGEN]) == tg, bar);
            __builtin_amdgcn_fence(__ATOMIC_ACQUIRE, "agent");
            xb_add(&bar[XB_XGEN(b.x)], 1u);
            asm volatile("s_waitcnt vmcnt(0)" ::: "memory");
        } else {
            XB_SPIN(xb_ld(&bar[XB_XGEN(b.x)]) == gen, bar);
            __builtin_amdgcn_fence(__ATOMIC_ACQUIRE, "agent");
            asm volatile("s_waitcnt vmcnt(0)" ::: "memory");
        }
    }
    __syncthreads();
}

__global__ void __launch_bounds__(512, 2) fwd_kernel(Params p) {
    extern __shared__ __attribute__((aligned(16))) unsigned char lds_raw[];
    LAS unsigned char* lds = (LAS unsigned char*)lds_raw;
    const int G = opq_gdim();
    float* MOD = (float*)(p.ws + WS_MOD);
    bf16_t* H = (bf16_t*)(p.ws + WS_H);
    bf16_t* PROJ = (bf16_t*)(p.ws + WS_PROJ);
    unsigned* barw = (unsigned*)(p.ws + WS_BAR);
    volatile LAS unsigned* bst = (volatile LAS unsigned*)(lds + LDS_MISC);
    XcdBarrier bar; bar.bar = barw; bar.x = 0; bar.st = bst;
    for (int ph = p.ph_lo; ph < p.ph_hi; ++ph) {
        if (ph == 0) {
            if (opq_bid() == 0) { for (int i = opq_tid(); i < XCD_BAR_WORDS + 256; i += 512) __hip_atomic_store(barw + i, 0u, __ATOMIC_RELAXED, __HIP_MEMORY_SCOPE_AGENT); __threadfence(); }
            if (opq_tid() == 0) { bst[0] = 0u; bst[1] = 0u; }
            phase_prologue(p, lds);
            continue;
        }
        if (ph > p.ph_lo) {
            if (ph == 1) { cg::this_grid().sync(); bar = xcd_barrier_post(barw, bst); }
            else xcd_barrier(bar);
        }
        const int l = (ph - 1) / 9, s = (ph - 1) % 9;
        const float* mod_l = MOD + (size_t)l * 8 * 6144;
        const bf16_t* WL = (const bf16_t*)(p.ws + WS_W) + (size_t)l * W_LAYER;
        const float* xin = (l == 0) ? p.x : p.out;
        if (EN(1) && s == 0) { phase_norm<true>(xin, p.norm_mix + l * DM, mod_l, 0, 1024, H, p.w_in + (size_t)l * 1024 * DIN, (float*)(p.ws + WS_BGATE)); }
        else if (EN(2) && s == 1) { pg8::Gemm g{H, WL + W_IN, MT, NP, DM}; pg8::StaticOrder S; S.init(MT, NP, G, opq_bid()); pg8::EpiStoreBf16 E{PROJ, NP};
            pg8::gemm_phase<pg8::EpiStoreBf16, pg8::StaticOrder, true, true>(lds, g, S, E); }
        else if (EN(3) && s == 2) { phase_hgrn_local(p, l, lds); __syncthreads(); phase_gdn_local(p, l, lds); }
        else if (EN(4) && s == 3) { phase_hgrn_scan(p); }
        else if (EN(5) && s == 4) {
            unsigned* ctr = barw + XCD_BAR_WORDS + 64 * (l + 1);
            volatile LAS int* qslot = (volatile LAS int*)(lds + LDS_MISC + 64);
            for (;;) {
                __syncthreads();
                if (opq_tid() == 0) *qslot = (int)__hip_atomic_fetch_add(ctr, 1u, __ATOMIC_RELAXED, __HIP_MEMORY_SCOPE_AGENT);
                __syncthreads();
                const int idx = *qslot;
                if (idx >= 32 + 512 + NUNIT / 2) break;
                if (idx < 32) gdn_scan_chain(p, l, lds, idx);
                else if (idx < 32 + 512) attn_item(p, l, lds, idx - 32);
                else phase_hgrn_out(p, l, lds, idx - (32 + 512), 1 << 30);
            }
        }
        else if (EN(6) && s == 5) { pg8::Gemm g{H, WL + W_OUT, MT, DM, DM}; pg8::StaticOrder S; S.init(MT, DM, G, opq_bid()); pg8::EpiGateRes E{xin, p.out, DM, mod_l + 2048, 6144, SEQ};
            pg8::gemm_phase<pg8::EpiGateRes, pg8::StaticOrder, true, true>(lds, g, S, E); }
        else if (EN(7) && s == 6) { phase_norm<false>(p.out, p.norm_ffn + l * DM, mod_l, 3072, 4096, H, nullptr, nullptr); }
        else if (EN(8) && s == 7) { pg8::Gemm g{H, WL + W_GU, MT, 2 * DFF, DM}; pg8::StaticOrder S; S.init(MT, 2 * DFF, G, opq_bid()); pg8::EpiSwiGlu E{PROJ, DFF};
            pg8::gemm_phase<pg8::EpiSwiGlu, pg8::StaticOrder, true, true>(lds, g, S, E); }
        else if (EN(9)) { pg8::Gemm g{PROJ, WL + W_DN, MT, DM, DFF}; pg8::StaticOrder S; S.init(MT, DM, G, opq_bid()); pg8::EpiGateRes E{p.out, p.out, DM, mod_l + 5120, 6144, SEQ};
            pg8::gemm_phase<pg8::EpiGateRes, pg8::StaticOrder, true, true>(lds, g, S, E); }
    }
}

extern "C" void kernel_launch(void* const* d_in, const int* in_sizes, int n_in, void* d_out, int out_size, void* d_ws, size_t ws_size, hipStream_t stream) {
    static int grid = 0;
    if (grid == 0) {
        if (n_in != 21 || in_sizes[0] != MT * DM || out_size != MT * DM || ws_size < WS_END) { fprintf(stderr, "kernel_launch: unexpected shapes (n_in %d, in0 %d, out %d, ws %zu)\n", n_in, n_in > 0 ? in_sizes[0] : -1, out_size, ws_size); grid = -1; return; }
        int dev = 0, cus = 0, per_cu = 0;
        if (hipGetDevice(&dev) != hipSuccess || hipDeviceGetAttribute(&cus, hipDeviceAttributeMultiprocessorCount, dev) != hipSuccess) { grid = -1; return; }
        if (hipFuncSetAttribute((const void*)fwd_kernel, hipFuncAttributeMaxDynamicSharedMemorySize, LDS_BYTES) != hipSuccess) { fprintf(stderr, "kernel_launch: hipFuncSetAttribute failed\n"); grid = -1; return; }
        if (hipOccupancyMaxActiveBlocksPerMultiprocessor(&per_cu, (const void*)fwd_kernel, 512, LDS_BYTES) != hipSuccess || per_cu < 1) { fprintf(stderr, "kernel_launch: occupancy query says %d\n", per_cu); (void)hipGetLastError(); per_cu = 1; }
        grid = cus * per_cu;
    }
    if (grid < 0) return;
    Params p{};
    p.x = (const float*)d_in[0]; p.c = (const float*)d_in[1]; p.pos = (const int*)d_in[2]; p.ada_w = (const float*)d_in[3]; p.ada_b = (const float*)d_in[4];
    p.norm_mix = (const float*)d_in[5]; p.w_in = (const float*)d_in[6]; p.qn = (const float*)d_in[7]; p.kn = (const float*)d_in[8]; p.sinks = (const float*)d_in[9];
    p.lb_logits = (const float*)d_in[10]; p.hgrn_norm = (const float*)d_in[11]; p.conv_w = (const float*)d_in[12]; p.a_log = (const float*)d_in[13]; p.dt_bias = (const float*)d_in[14];
    p.gdn_norm = (const float*)d_in[15]; p.w_out = (const float*)d_in[16]; p.norm_ffn = (const float*)d_in[17]; p.w_gate = (const float*)d_in[18]; p.w_up = (const float*)d_in[19];
    p.w_down = (const float*)d_in[20]; p.out = (float*)d_out; p.ws = (unsigned char*)d_ws;
    p.ph_lo = 0; p.ph_hi = NPHASE;
    void* args[] = {&p};
    const hipError_t e = hipLaunchCooperativeKernel((const void*)fwd_kernel, dim3(grid), dim3(512), args, LDS_BYTES, stream);
    if (e != hipSuccess) fprintf(stderr, "kernel_launch: cooperative launch failed: %s (grid %d)\n", hipGetErrorString(e), grid);
}
```

```cpp
#include <hip/hip_runtime.h>
#include <hip/hip_cooperative_groups.h>
#include <cstdio>
#include <cstdint>
namespace cg = cooperative_groups;

__device__ __forceinline__ int opq_tid() { int t = threadIdx.x; asm volatile("" : "+v"(t)); return t; }
__device__ __forceinline__ int opq_bid() { int t = blockIdx.x; asm volatile("" : "+s"(t)); return t; }
__device__ __forceinline__ int opq_gdim() { int t = gridDim.x; asm volatile("" : "+s"(t)); return t; }
namespace pg8 {
#define PG8_LAS __attribute__((address_space(3)))
typedef unsigned short bf16_t;
typedef short bf16x8 __attribute__((ext_vector_type(8)));
typedef float f32x4 __attribute__((ext_vector_type(4)));
typedef unsigned u32x4 __attribute__((ext_vector_type(4)));
constexpr int BM = 256, BK = 64, HALF = 128, HTB = HALF * BK * 2  , STAGE_BYTES = 8 * HTB, NXCD = 8, WGM = 8;

__host__ __device__ __forceinline__ int lds_byte(int r, int c) { const int st = (r >> 4) * 2 + (c >> 5), rr = r & 15, cc = c & 31, ob = rr * 64 + cc * 2; return st * 1024 + (ob ^ (((ob >> 9) & 1) << 5)); }
__host__ __device__ __forceinline__ void stage_rc(int b, int& R, int& C) { const int st = b / 1024, sb = b % 1024, swz = sb ^ (((sb >> 9) & 1) << 5); R = (st >> 1) * 16 + swz / 64; C = (st & 1) * 32 + (swz % 64) / 2; }
__host__ __device__ __forceinline__ int perm32(int rho) { const int n = rho >> 4, i = rho & 15; return 8 * (i >> 2) + 4 * n + (i & 3); }

struct Unit { int pm, pn; };
struct Gemm { const bf16_t* A; const bf16_t* Bt; int M, N, K; };

struct StaticOrder {
    int nM, nN, nwg, G, c;
    __host__ __device__ void init(int M, int N, int G_, int c_) { nM = M / BM; nN = N / BM; nwg = nM * nN; G = G_; c = c_; }
    __host__ __device__ bool next(int i, Unit& u) const {
        const long L = (long)i * G + c; if (L >= nwg) return false;
        int wgid = (int)L; { const int q = nwg / NXCD, r = nwg % NXCD, xcd = wgid % NXCD, off = wgid / NXCD; wgid = (xcd < r ? xcd * (q + 1) : r * (q + 1) + (xcd - r) * q) + off; }
        const int nig = WGM * nN, gid = wgid / nig, fm = gid * WGM, gsz = (nM - fm) < WGM ? (nM - fm) : WGM;
        u.pm = fm + ((wgid % nig) % gsz); u.pn = (wgid % nig) / gsz; return true;
    }
    __device__ __forceinline__ void a_ready(const Unit&) const {}
    __device__ __forceinline__ void done(const Unit&) const {}
};

__device__ __forceinline__ unsigned cvt_pk_bf16(float lo, float hi) { unsigned r; asm volatile("v_cvt_pk_bf16_f32 %0, %1, %2" : "=v"(r) : "v"(lo), "v"(hi)); return r; }
typedef float f32x2 __attribute__((ext_vector_type(2)));
__device__ __forceinline__ f32x2 gelu_pk(f32x2 v) {
    const f32x2 av = __builtin_elementwise_abs(v), d = av * 0.2316418882f + 1.0f;
    f32x2 t; t.x = __builtin_amdgcn_rcpf(d.x); t.y = __builtin_amdgcn_rcpf(d.y);
    f32x2 q = t * 0.5307027145f + (-0.7265760135f); q = q * t + 0.7107068705f; q = q * t + (-0.142248368f); q = q * t + 0.127414796f; q = q * t;
    const f32x2 s = (v * v) * (-0.72134752044f);
    f32x2 e; e.x = __builtin_amdgcn_exp2f(s.x); e.y = __builtin_amdgcn_exp2f(s.y);
    const f32x2 m = v * (q * e), r = v - m;
    f32x2 o; o.x = v.x < 0.f ? m.x : r.x; o.y = v.y < 0.f ? m.y : r.y; return o;
}

struct EpiStoreBf16 {
    static constexpr bool PERM = true, AFTER_DRAIN = false;
    bf16_t* O; int ldc;
    __device__ __forceinline__ void operator()(const f32x4 (&acc)[2][2][4][2], const Unit& u, int wr, int wc, int fr, int fq) const {
        const int row0 = u.pm * BM + wr * 64 + fr, col0 = u.pn * BM + wc * 32 + 8 * fq;
#pragma unroll
        for (int ai = 0; ai < 2; ++ai)
#pragma unroll
            for (int m = 0; m < 4; ++m) { bf16_t* rowp = O + (size_t)(row0 + ai * HALF + m * 16) * ldc + col0;
#pragma unroll
                for (int bj = 0; bj < 2; ++bj) { const f32x4 v0 = acc[ai][bj][m][0], v1 = acc[ai][bj][m][1];
                    u32x4 w; w.x = cvt_pk_bf16(v0[0], v0[1]); w.y = cvt_pk_bf16(v0[2], v0[3]); w.z = cvt_pk_bf16(v1[0], v1[1]); w.w = cvt_pk_bf16(v1[2], v1[3]);
                    *(u32x4*)(rowp + bj * HALF) = w; } }
    }
};
struct EpiSwiGlu {
    static constexpr bool PERM = true, AFTER_DRAIN = false;
    bf16_t* O; int ldc;
    __device__ __forceinline__ void operator()(const f32x4 (&acc)[2][2][4][2], const Unit& u, int wr, int wc, int fr, int fq) const {
        const int row0 = u.pm * BM + wr * 64 + fr, col0 = u.pn * HALF + wc * 32 + 8 * fq;
#pragma unroll
        for (int ai = 0; ai < 2; ++ai)
#pragma unroll
            for (int m = 0; m < 4; ++m) { bf16_t* rowp = O + (size_t)(row0 + ai * HALF + m * 16) * ldc + col0;
                float r[8];
#pragma unroll
                for (int n = 0; n < 2; ++n)
#pragma unroll
                    for (int i = 0; i < 4; ++i) { const float g = acc[ai][0][m][n][i], up = acc[ai][1][m][n][i]; r[n * 4 + i] = g * __builtin_amdgcn_rcpf(1.0f + __expf(-g)) * up; }
                u32x4 w; w.x = cvt_pk_bf16(r[0], r[1]); w.y = cvt_pk_bf16(r[2], r[3]); w.z = cvt_pk_bf16(r[4], r[5]); w.w = cvt_pk_bf16(r[6], r[7]);
                *(u32x4*)rowp = w; }
    }
};
struct EpiGateRes {
    static constexpr bool PERM = false, AFTER_DRAIN = false;
    const float* base; float* out; int ldc; const float* gate; int gate_stride; int rows_per_batch;
    __device__ __forceinline__ void operator()(const f32x4 (&acc)[2][2][4][2], const Unit& u, int wr, int wc, int fr, int fq) const {
        const int col0 = u.pn * BM + wc * 32 + 4 * fq;
        const float* gp = gate + (size_t)((u.pm * BM) / rows_per_batch) * gate_stride + col0;
        f32x4 gv[2][2];
#pragma unroll
        for (int bj = 0; bj < 2; ++bj)
#pragma unroll
            for (int n = 0; n < 2; ++n) gv[bj][n] = *(const f32x4*)(gp + bj * HALF + n * 16);
#pragma unroll
        for (int ai = 0; ai < 2; ++ai)
#pragma unroll
            for (int mp = 0; mp < 2; ++mp) {
                f32x4 pre[2][2][2];
#pragma unroll
                for (int mm = 0; mm < 2; ++mm) { const size_t off = (size_t)(u.pm * BM + ai * HALF + wr * 64 + (2 * mp + mm) * 16 + fr) * ldc + col0;
#pragma unroll
                    for (int bj = 0; bj < 2; ++bj)
#pragma unroll
                        for (int n = 0; n < 2; ++n) pre[mm][bj][n] = *(const f32x4*)(base + off + bj * HALF + n * 16); }
#pragma unroll
                for (int mm = 0; mm < 2; ++mm) { const size_t off = (size_t)(u.pm * BM + ai * HALF + wr * 64 + (2 * mp + mm) * 16 + fr) * ldc + col0;
#pragma unroll
                    for (int bj = 0; bj < 2; ++bj)
#pragma unroll
                        for (int n = 0; n < 2; ++n) *(f32x4*)(out + off + bj * HALF + n * 16) = pre[mm][bj][n] + gv[bj][n] * acc[ai][bj][2 * mp + mm][n]; }
                asm volatile("" ::: "memory");
            }
    }
};
template <class Epi, class Sched, bool ALIGN_EPI = false, bool SP2 = false>
__device__ __forceinline__ void gemm_phase(PG8_LAS unsigned char* lds, const Gemm g, const Sched& S, const Epi& E) {
    const int tid = opq_tid(), wid = __builtin_amdgcn_readfirstlane(tid >> 6), lane = tid & 63, wr = wid >> 2, wc = wid & 3, fr = lane & 15, fq = lane >> 4;
    const int K = g.K, nt = K / BK;
    unsigned voffA[2], voffB[2];
#pragma unroll
    for (int i = 0; i < 2; ++i) { int R, C; stage_rc(tid * 16 + i * 8192, R, C); const int Rb = Epi::PERM ? ((R & ~31) + perm32(R & 31)) : R;
        voffA[i] = (unsigned)(R * K + C) * 2u; voffB[i] = (unsigned)(Rb * K + C) * 2u; }
    const size_t kstep = (size_t)(BK * 2);
    const size_t hstep = (size_t)HALF * K * 2;
    const size_t tstep = 2 * hstep;
    const unsigned ldsw = (unsigned)wid * 1024u;
    const int aoff = lds_byte(wr * 64 + fr, fq * 8), boff = lds_byte(wc * 32 + fr, fq * 8);
#define PG8_SA(b, h) (((b) * 2 + (h)) * HTB)
#define PG8_SB(b, h) ((4 + (b) * 2 + (h)) * HTB)
#define PG8_STAGE(bufoff, gbase, voff) do { _Pragma("unroll") for (int _i = 0; _i < 2; ++_i) \
        __builtin_amdgcn_global_load_lds((const unsigned*)((const char*)(gbase) + (voff)[_i]), (PG8_LAS unsigned*)(lds + (bufoff) + ldsw + _i * 8192), 16, 0, 0); } while (0)
#define PG8_LDA(dst, b, h) do { _Pragma("unroll") for (int m = 0; m < 4; ++m) _Pragma("unroll") for (int k = 0; k < 2; ++k) dst[m][k] = *(const PG8_LAS bf16x8*)(lds + PG8_SA(b, h) + aoff + m * 2048 + k * 1024); } while (0)
#define PG8_LDB(dst, b, h) do { _Pragma("unroll") for (int n = 0; n < 2; ++n) _Pragma("unroll") for (int k = 0; k < 2; ++k) dst[n][k] = *(const PG8_LAS bf16x8*)(lds + PG8_SB(b, h) + boff + n * 2048 + k * 1024); } while (0)
#define PG8_MMA(ai, bj, At, Bt) do { __builtin_amdgcn_s_setprio(1); _Pragma("unroll") for (int m = 0; m < 4; ++m) _Pragma("unroll") for (int n = 0; n < 2; ++n) _Pragma("unroll") for (int k = 0; k < 2; ++k) \
        acc[ai][bj][m][n] = __builtin_amdgcn_mfma_f32_16x16x32_bf16(Bt[n][k], At[m][k], acc[ai][bj][m][n], 0, 0, 0); __builtin_amdgcn_s_setprio(0); } while (0)
#define PG8_WAIT_V(n) asm volatile("s_waitcnt vmcnt(" #n ")" ::: "memory")
#define PG8_WAIT_L(n) asm volatile("s_waitcnt lgkmcnt(" #n ")" ::: "memory")
#define PG8_BAR __builtin_amdgcn_s_barrier()
#define PG8_SCHED __builtin_amdgcn_sched_barrier(0)
    Unit cur, nxt; int ui = 0;
    if (!S.next(0, cur)) return;
    f32x4 acc[2][2][4][2];
#pragma unroll
    for (int a = 0; a < 2; ++a)
#pragma unroll
        for (int b = 0; b < 2; ++b)
#pragma unroll
            for (int m = 0; m < 4; ++m)
#pragma unroll
                for (int n = 0; n < 2; ++n) acc[a][b][m][n] = (f32x4){0.f, 0.f, 0.f, 0.f};
    bf16x8 At[4][2], B0[2][2], B1[2][2];
    const char* cA = (const char*)g.A + (size_t)cur.pm * tstep; const char* cB = (const char*)g.Bt + (size_t)cur.pn * tstep;
    S.a_ready(cur);
    if constexpr (SP2) {
        PG8_STAGE(PG8_SB(0, 0), cB, voffB); PG8_STAGE(PG8_SB(0, 1), cB + hstep, voffB); PG8_STAGE(PG8_SA(0, 0), cA, voffA); PG8_STAGE(PG8_SA(0, 1), cA + hstep, voffA);
        if (wr == 1) PG8_BAR;
        PG8_WAIT_V(2); PG8_BAR;
        PG8_STAGE(PG8_SB(1, 0), cB + kstep, voffB); PG8_STAGE(PG8_SA(1, 0), cA + kstep, voffA); PG8_STAGE(PG8_SB(1, 1), cB + hstep + kstep, voffB);
        PG8_WAIT_V(6); PG8_BAR;
    } else {
        PG8_STAGE(PG8_SB(0, 0), cB, voffB); PG8_STAGE(PG8_SA(0, 0), cA, voffA); PG8_STAGE(PG8_SB(0, 1), cB + hstep, voffB); PG8_STAGE(PG8_SA(0, 1), cA + hstep, voffA);
        if (wr == 1) PG8_BAR;
        PG8_WAIT_V(4); PG8_BAR;
        PG8_STAGE(PG8_SB(1, 0), cB + kstep, voffB); PG8_STAGE(PG8_SA(1, 0), cA + kstep, voffA); PG8_STAGE(PG8_SB(1, 1), cB + hstep + kstep, voffB);
        PG8_WAIT_V(6); PG8_BAR;
    }
    for (;;) {
        const bool has_next = S.next(ui + 1, nxt);
        const char* nA = has_next ? (const char*)g.A + (size_t)nxt.pm * tstep : cA; const char* nB = has_next ? (const char*)g.Bt + (size_t)nxt.pn * tstep : cB;
        for (int t = 0; t < nt; t += 2) {
            const bool last = (t == nt - 2);
            const char* a1 = cA + (size_t)(t + 1) * kstep;
            const char* a2 = last ? nA : cA + (size_t)(t + 2) * kstep; const char* b2 = last ? nB : cB + (size_t)(t + 2) * kstep;
            const char* a3 = a2 + kstep; const char* b3 = b2 + kstep;
            if (last && has_next) S.a_ready(nxt);
            if constexpr (SP2) {
            PG8_LDB(B0, 0, 0); PG8_LDB(B1, 0, 1); PG8_SCHED; PG8_LDA(At, 0, 0); PG8_STAGE(PG8_SA(1, 1), a1 + hstep, voffA);
            PG8_WAIT_V(8); PG8_WAIT_L(0); PG8_BAR; PG8_MMA(0, 0, At, B0); PG8_MMA(0, 1, At, B1); PG8_BAR; PG8_SCHED;
            PG8_LDA(At, 0, 1); PG8_STAGE(PG8_SB(0, 0), b2, voffB); PG8_STAGE(PG8_SB(0, 1), b2 + hstep, voffB); PG8_STAGE(PG8_SA(0, 0), a2, voffA);
            PG8_WAIT_V(8); PG8_WAIT_L(0); PG8_BAR; PG8_MMA(1, 0, At, B0); PG8_MMA(1, 1, At, B1); PG8_BAR; PG8_SCHED;
            PG8_LDB(B0, 1, 0); PG8_LDB(B1, 1, 1); PG8_SCHED; PG8_LDA(At, 1, 0); PG8_STAGE(PG8_SA(0, 1), a2 + hstep, voffA);
            PG8_WAIT_V(8); PG8_WAIT_L(0); PG8_BAR; PG8_MMA(0, 0, At, B0); PG8_MMA(0, 1, At, B1); PG8_BAR; PG8_SCHED;
            PG8_LDA(At, 1, 1); PG8_STAGE(PG8_SB(1, 0), b3, voffB); PG8_STAGE(PG8_SB(1, 1), b3 + hstep, voffB); PG8_STAGE(PG8_SA(1, 0), a3, voffA);
            PG8_WAIT_V(8); PG8_WAIT_L(0); PG8_BAR; PG8_MMA(1, 0, At, B0); PG8_MMA(1, 1, At, B1); PG8_BAR; PG8_SCHED;
            } else {
            PG8_LDB(B0, 0, 0); PG8_SCHED; PG8_LDA(At, 0, 0); PG8_STAGE(PG8_SA(1, 1), a1 + hstep, voffA);
            PG8_WAIT_L(8); PG8_BAR; PG8_WAIT_L(0); PG8_MMA(0, 0, At, B0); PG8_BAR; PG8_SCHED;
            PG8_LDB(B1, 0, 1); PG8_STAGE(PG8_SB(0, 0), b2, voffB);
            PG8_BAR; PG8_WAIT_L(0); PG8_MMA(0, 1, At, B1); PG8_BAR;
            PG8_LDA(At, 0, 1); PG8_STAGE(PG8_SA(0, 0), a2, voffA);
            PG8_BAR; PG8_WAIT_L(0); PG8_MMA(1, 0, At, B0); PG8_BAR; PG8_SCHED;
            PG8_STAGE(PG8_SB(0, 1), b2 + hstep, voffB);
            PG8_WAIT_V(6); PG8_BAR; PG8_MMA(1, 1, At, B1); PG8_BAR;
            PG8_LDB(B0, 1, 0); PG8_SCHED; PG8_LDA(At, 1, 0); PG8_STAGE(PG8_SA(0, 1), a2 + hstep, voffA);
            PG8_WAIT_L(8); PG8_BAR; PG8_WAIT_L(0); PG8_MMA(0, 0, At, B0); PG8_BAR; PG8_SCHED;
            PG8_LDB(B1, 1, 1); PG8_STAGE(PG8_SB(1, 0), b3, voffB);
            PG8_BAR; PG8_WAIT_L(0); PG8_MMA(0, 1, At, B1); PG8_BAR;
            PG8_LDA(At, 1, 1); PG8_STAGE(PG8_SA(1, 0), a3, voffA);
            PG8_BAR; PG8_WAIT_L(0); PG8_MMA(1, 0, At, B0); PG8_BAR; PG8_SCHED;
            PG8_STAGE(PG8_SB(1, 1), b3 + hstep, voffB);
            PG8_WAIT_V(6); PG8_BAR; PG8_MMA(1, 1, At, B1); PG8_BAR;
            }
        }
        if constexpr (ALIGN_EPI) { if (wr == 0) PG8_BAR; }
        if constexpr (!Epi::AFTER_DRAIN) { E(acc, cur, wr, wc, fr, fq); S.done(cur); }
        if (!has_next) break;
#pragma unroll
        for (int a = 0; a < 2; ++a)
#pragma unroll
            for (int b = 0; b < 2; ++b)
#pragma unroll
                for (int m = 0; m < 4; ++m)
#pragma unroll
                    for (int n = 0; n < 2; ++n) acc[a][b][m][n] = (f32x4){0.f, 0.f, 0.f, 0.f};
        cur = nxt; cA = nA; cB = nB; ++ui;
        if constexpr (ALIGN_EPI) { if (wr == 1) PG8_BAR; }
    }
    PG8_WAIT_V(0);
    if constexpr (!ALIGN_EPI) { if (wr == 0) PG8_BAR; }
    PG8_BAR;
    if constexpr (Epi::AFTER_DRAIN) { E.fused(acc, cur, wr, wc, fr, fq, lds, wid, lane); S.done(cur); }
#undef PG8_SA
#undef PG8_SB
#undef PG8_STAGE
#undef PG8_LDA
#undef PG8_LDB
#undef PG8_MMA
#undef PG8_WAIT_V
#undef PG8_WAIT_L
#undef PG8_BAR
#undef PG8_SCHED
}
}

#define DI __device__ __forceinline__
#define LAS __attribute__((address_space(3)))
using pg8::bf16_t; using pg8::bf16x8; using pg8::f32x4; using pg8::u32x4; using pg8::cvt_pk_bf16;
typedef short s16x4 __attribute__((ext_vector_type(4)));
typedef unsigned u32x2 __attribute__((ext_vector_type(2)));


constexpr int NB = 8, SEQ = 4096, DM = 1024, MT = NB * SEQ;
constexpr int DIN = 2824, NP = 2816, DFF = 2816;
constexpr int C_AQ = 0, C_AK = 512, C_AV = 640, C_BQ = 768, C_BF = 1024, C_BV = 1280, C_BG = 1536, C_CQ = 1792, C_CK = 2048, C_CV = 2304, C_CG = 2560;
constexpr int NUNIT = NB * 64 * 4;
constexpr float EPS = 1e-6f;
constexpr int LDS_BYTES = 147456;
constexpr int LDS_MISC = LDS_BYTES - 256;
constexpr int NPHASE = 19;
#ifndef PH_MASK
#define PH_MASK 0x3ff
#endif
#define EN(k) (((PH_MASK) >> (k)) & 1)

constexpr size_t MiB = 1u << 20;
constexpr size_t WS_BAR = 512 * 1024;
constexpr size_t WS_MOD = 0, WS_ROPE = 1 * MiB, WS_BGATE = 3 * MiB, WS_W = 4 * MiB, WS_H = 52 * MiB, WS_PROJ = 116 * MiB, WS_BST = 292 * MiB, WS_BDEC = 324 * MiB,
                 WS_CGL = 325 * MiB, WS_CU = 326 * MiB, WS_CW = 358 * MiB, WS_CKD = 390 * MiB, WS_CQD = 406 * MiB, WS_CQK = 422 * MiB, WS_CO = 438 * MiB, WS_BST2 = 470 * MiB, WS_END = 502 * MiB;
constexpr size_t W_IN = 0, W_OUT = (size_t)2816 * 1024, W_GU = W_OUT + (size_t)1024 * 1024, W_DN = W_GU + (size_t)5632 * 1024, W_LAYER = W_DN + (size_t)1024 * 2816;

struct Params {
    const float *x, *c; const int* pos; const float *ada_w, *ada_b, *norm_mix, *w_in, *qn, *kn, *sinks, *lb_logits, *hgrn_norm, *conv_w, *a_log, *dt_bias, *gdn_norm, *w_out,
        *norm_ffn, *w_gate, *w_up, *w_down;
    float* out; unsigned char* ws; int ph_lo, ph_hi;
};

DI float bf2f(bf16_t v) { return __uint_as_float((unsigned)v << 16); }
DI bf16_t f2bf(float f) { const unsigned u = __float_as_uint(f); return (bf16_t)((u + 0x7fffu + ((u >> 16) & 1u)) >> 16); }
#define LDS_BARRIER() do { asm volatile("s_waitcnt lgkmcnt(0)" ::: "memory"); __builtin_amdgcn_s_barrier(); asm volatile("" ::: "memory"); } while (0)
DI float wave_sum(float v) {
#pragma unroll
    for (int o = 32; o >= 1; o >>= 1) v += __shfl_xor(v, o);
    return v;
}
DI float fexp(float x) { return __expf(x); }
DI float frcp(float x) { return __builtin_amdgcn_rcpf(x); }
DI float row16_sum(float s) {
    s += __int_as_float(__builtin_amdgcn_mov_dpp(__float_as_int(s), 0x128, 0xf, 0xf, false));
    s += __int_as_float(__builtin_amdgcn_mov_dpp(__float_as_int(s), 0x124, 0xf, 0xf, false));
    s += __int_as_float(__builtin_amdgcn_mov_dpp(__float_as_int(s), 0x122, 0xf, 0xf, false));
    s += __int_as_float(__builtin_amdgcn_mov_dpp(__float_as_int(s), 0x121, 0xf, 0xf, false));
    return s;
}
DI float wave_sum_dpp(float v) {
    v += __int_as_float(__builtin_amdgcn_mov_dpp(__float_as_int(v), 0xB1, 0xf, 0xf, false));
    v += __int_as_float(__builtin_amdgcn_mov_dpp(__float_as_int(v), 0x4E, 0xf, 0xf, false));
    v += __int_as_float(__builtin_amdgcn_mov_dpp(__float_as_int(v), 0x141, 0xf, 0xf, false));
    v += __int_as_float(__builtin_amdgcn_mov_dpp(__float_as_int(v), 0x140, 0xf, 0xf, false));
    v += __int_as_float(__builtin_amdgcn_update_dpp(0, __float_as_int(v), 0x142, 0xa, 0xf, false));
    v += __int_as_float(__builtin_amdgcn_update_dpp(0, __float_as_int(v), 0x143, 0xc, 0xf, false));
    return __int_as_float(__builtin_amdgcn_readlane(__float_as_int(v), 63));
}
DI float xrow4_sum(float s) {
    { auto r = __builtin_amdgcn_permlane32_swap(__float_as_uint(s), __float_as_uint(s), false, false); s = __uint_as_float(r[0]) + __uint_as_float(r[1]); }
    { auto r = __builtin_amdgcn_permlane16_swap(__float_as_uint(s), __float_as_uint(s), false, false); s = __uint_as_float(r[0]) + __uint_as_float(r[1]); }
    return s;
}
DI float silu_f(float v) { return v * frcp(1.0f + fexp(-v)); }
DI void unpack8(const u32x4 w, float* x) {
    x[0] = __uint_as_float(w.x << 16); x[1] = __uint_as_float(w.x & 0xffff0000u); x[2] = __uint_as_float(w.y << 16); x[3] = __uint_as_float(w.y & 0xffff0000u);
    x[4] = __uint_as_float(w.z << 16); x[5] = __uint_as_float(w.z & 0xffff0000u); x[6] = __uint_as_float(w.w << 16); x[7] = __uint_as_float(w.w & 0xffff0000u);
}
DI u32x4 pack8(const float* x) { u32x4 w; w.x = cvt_pk_bf16(x[0], x[1]); w.y = cvt_pk_bf16(x[2], x[3]); w.z = cvt_pk_bf16(x[4], x[5]); w.w = cvt_pk_bf16(x[6], x[7]); return w; }

constexpr int LD = 72;
DI void mm16x64(f32x4 (&acc)[4], const LAS bf16_t* Arow, const LAS bf16_t* B, int lane) {
    const int r = lane & 15, q = lane >> 4;
    bf16x8 a[2], b[2][4];
#pragma unroll
    for (int ks = 0; ks < 2; ++ks) { a[ks] = *(const LAS bf16x8*)(Arow + r * LD + ks * 32 + q * 8);
#pragma unroll
        for (int nt = 0; nt < 4; ++nt) b[ks][nt] = *(const LAS bf16x8*)(B + (nt * 16 + r) * LD + ks * 32 + q * 8); }
    __builtin_amdgcn_sched_barrier(0);
#pragma unroll
    for (int ks = 0; ks < 2; ++ks)
#pragma unroll
        for (int nt = 0; nt < 4; ++nt) acc[nt] = __builtin_amdgcn_mfma_f32_16x16x32_bf16(a[ks], b[ks][nt], acc[nt], 0, 0, 0);
    __builtin_amdgcn_sched_barrier(0);
}

DI void transpose_item(const float* W, int ld, int K, bf16_t* WT, int n0, int dst_row0, int k0, LAS float* scr, int lane) {
#pragma unroll 8
    for (int i = 0; i < 32; ++i) { const int kk = 2 * i + (lane >> 5); scr[kk * 33 + (lane & 31)] = W[(size_t)(k0 + kk) * ld + n0 + (lane & 31)]; }
    asm volatile("s_waitcnt lgkmcnt(0)" ::: "memory");
    const int c = lane & 7;
#pragma unroll
    for (int j = 0; j < 4; ++j) { const int n = (lane >> 3) + 8 * j; const LAS float* s = scr + (8 * c) * 33 + n;
        u32x4 o; o.x = cvt_pk_bf16(s[0 * 33], s[1 * 33]); o.y = cvt_pk_bf16(s[2 * 33], s[3 * 33]); o.z = cvt_pk_bf16(s[4 * 33], s[5 * 33]); o.w = cvt_pk_bf16(s[6 * 33], s[7 * 33]);
        *(u32x4*)(WT + (size_t)(dst_row0 + n) * K + k0 + 8 * c) = o; }
    asm volatile("s_waitcnt lgkmcnt(0)" ::: "memory");
}

DI void phase_prologue(const Params& p, LAS unsigned char* lds) {
    const int tid = opq_tid(), lane = tid & 63, wave = tid >> 6, G = opq_gdim();
    float* MOD = (float*)(p.ws + WS_MOD);
    LAS float* cs = (LAS float*)lds;
    LAS float* red = (LAS float*)(lds + 32768);
    for (int it = opq_bid(); it < 192; it += G) {
        const int l = it / 96, cgp = it % 96;
        __syncthreads();
        for (int i = tid; i < 8192; i += 512) { const float v = p.c[i]; cs[i] = v / (1.0f + expf(-v)); }
        __syncthreads();
        float acc[8];
#pragma unroll
        for (int b = 0; b < 8; ++b) acc[b] = 0.f;
        const float* wp = p.ada_w + (size_t)l * 1024 * 6144 + (size_t)(wave * 128) * 6144 + cgp * 64 + lane;
#pragma unroll 8
        for (int k = 0; k < 128; ++k) { const float wv = wp[(size_t)k * 6144];
#pragma unroll
            for (int b = 0; b < 8; ++b) acc[b] += cs[b * 1024 + wave * 128 + k] * wv; }
#pragma unroll
        for (int b = 0; b < 8; ++b) red[(wave * 8 + b) * 64 + lane] = acc[b];
        __syncthreads();
        { const int b = tid >> 6; float s = p.ada_b[l * 6144 + cgp * 64 + lane];
#pragma unroll
          for (int w = 0; w < 8; ++w) s += red[(w * 8 + b) * 64 + lane];
          MOD[(size_t)(l * 8 + b) * 6144 + cgp * 64 + lane] = s; }
    }
    __syncthreads();
    float* ROPE = (float*)(p.ws + WS_ROPE);
    for (int i = opq_bid() * 512 + tid; i < MT * 8; i += G * 512) {
        const int tok = i >> 3, f = i & 7;
        const float inv = powf(500000.0f, -(float)f * 0.125f);
        const float ang = (float)p.pos[tok] * inv;
        ROPE[tok * 16 + f] = cosf(ang); ROPE[tok * 16 + 8 + f] = sinf(ang);
    }
    LAS float* scr = (LAS float*)(lds + wave * 16384);
    const int gw = opq_bid() * 8 + wave, NGW = G * 8;
    for (int it = gw; it < 2 * 6144; it += NGW) {
        const int l = it / 6144; int r = it % 6144;
        bf16_t* WL = (bf16_t*)(p.ws + WS_W) + (size_t)l * W_LAYER;
        if (r < 1408) { const int kb = r / 88, nb = r % 88; transpose_item(p.w_in + (size_t)l * 1024 * DIN, DIN, 1024, WL + W_IN, 32 * nb, 32 * nb, 64 * kb, scr, lane); continue; } r -= 1408;
        if (r < 512) { const int kb = r / 32, nb = r % 32; transpose_item(p.w_out + (size_t)l * 1024 * 1024, 1024, 1024, WL + W_OUT, 32 * nb, 32 * nb, 64 * kb, scr, lane); continue; } r -= 512;
        if (r < 1408) { const int kb = r / 88, n0 = 32 * (r % 88); transpose_item(p.w_gate + (size_t)l * 1024 * DFF, DFF, 1024, WL + W_GU, n0, (n0 / 128) * 256 + (n0 % 128), 64 * kb, scr, lane); continue; } r -= 1408;
        if (r < 1408) { const int kb = r / 88, n0 = 32 * (r % 88); transpose_item(p.w_up + (size_t)l * 1024 * DFF, DFF, 1024, WL + W_GU, n0, (n0 / 128) * 256 + 128 + (n0 % 128), 64 * kb, scr, lane); continue; } r -= 1408;
        { const int kb = r / 32, nb = r % 32; transpose_item(p.w_down + (size_t)l * DFF * 1024, 1024, DFF, WL + W_DN, 32 * nb, 32 * nb, 64 * kb, scr, lane); }
    }
}

template <bool BGATE>
DI void phase_norm(const float* xin, const float* gain, const float* mod_l, int sh_off, int sc_off, bf16_t* H, const float* w_in_l, float* BGo) {
    const int tid = opq_tid(), lane = tid & 63, wave = tid >> 6;
    const int gw = opq_bid() * 8 + wave, NGW = opq_gdim() * 8;
    f32x4 w8[4][4][2];
    if (BGATE) {
#pragma unroll
        for (int j = 0; j < 4; ++j)
#pragma unroll
            for (int i = 0; i < 4; ++i) { const float* wp = w_in_l + (size_t)(4 * lane + 256 * j + i) * DIN + NP; w8[j][i][0] = *(const f32x4*)wp; w8[j][i][1] = *(const f32x4*)(wp + 4); }
    }
    for (int rg = gw; rg < MT / 16; rg += NGW) {
        const int row0 = rg * 16, b = row0 / SEQ;
        f32x4 A[4], S[4];
#pragma unroll
        for (int j = 0; j < 4; ++j) { const int k0 = 4 * lane + 256 * j;
            const f32x4 g = *(const f32x4*)(gain + k0), sc = *(const f32x4*)(mod_l + (size_t)b * 6144 + sc_off + k0);
            A[j] = g * (sc + 1.0f); S[j] = *(const f32x4*)(mod_l + (size_t)b * 6144 + sh_off + k0); }
        f32x4 nx[4];
#pragma unroll
        for (int j = 0; j < 4; ++j) nx[j] = *(const f32x4*)(xin + (size_t)row0 * DM + 4 * lane + 256 * j);
        for (int r = 0; r < 16; ++r) {
            f32x4 v[4]; float ss = 0.f;
#pragma unroll
            for (int j = 0; j < 4; ++j) { v[j] = nx[j]; ss += (v[j][0] * v[j][0] + v[j][1] * v[j][1]) + (v[j][2] * v[j][2] + v[j][3] * v[j][3]); }
            if (!BGATE) { const float* xr = xin + (size_t)(row0 + (r < 15 ? r + 1 : r)) * DM + 4 * lane;
#pragma unroll
              for (int j = 0; j < 4; ++j) nx[j] = *(const f32x4*)(xr + 256 * j); }
            ss = wave_sum(ss);
            const float rstd = rsqrtf(ss * (1.0f / DM) + EPS);
            bf16_t* hr = H + (size_t)(row0 + r) * DM + 4 * lane;
#pragma unroll
            for (int j = 0; j < 4; ++j) { v[j] = v[j] * rstd * A[j] + S[j]; u32x2 w; w.x = cvt_pk_bf16(v[j][0], v[j][1]); w.y = cvt_pk_bf16(v[j][2], v[j][3]); *(u32x2*)(hr + 256 * j) = w; }
            if (BGATE) {
                f32x4 s0 = {0.f, 0.f, 0.f, 0.f}, s1 = {0.f, 0.f, 0.f, 0.f};
#pragma unroll
                for (int j = 0; j < 4; ++j)
#pragma unroll
                    for (int i = 0; i < 4; ++i) { s0 += w8[j][i][0] * v[j][i]; s1 += w8[j][i][1] * v[j][i]; }
#pragma unroll
                for (int c = 0; c < 4; ++c) { s0[c] = wave_sum(s0[c]); s1[c] = wave_sum(s1[c]); }
                if (lane == 0) { *(f32x4*)(BGo + (size_t)(row0 + r) * 8) = s0; *(f32x4*)(BGo + (size_t)(row0 + r) * 8 + 4) = s1; }
                const float* xr = xin + (size_t)(row0 + (r < 15 ? r + 1 : r)) * DM + 4 * lane;
#pragma unroll
                for (int j = 0; j < 4; ++j) nx[j] = *(const f32x4*)(xr + 256 * j);
            }
        }
    }
}

DI void attn_item(const Params& p, int l, LAS unsigned char* lds, int item) {
    const int tid = opq_tid(), lane = tid & 63, w = tid >> 6;
    const bf16_t* PR = (const bf16_t*)(p.ws + WS_PROJ);
    bf16_t* MIX = (bf16_t*)(p.ws + WS_H);
    const float* ROPE = (const float*)(p.ws + WS_ROPE);
    const float* qn = p.qn + l * 64; const float* kn = p.kn + l * 64; const float* sinks = p.sinks + l * 8;
    LAS bf16_t* Ks = (LAS bf16_t*)lds;
    LAS bf16_t* Vt = (LAS bf16_t*)(lds + 36864);
    LAS bf16_t* Qs = (LAS bf16_t*)(lds + 70656);
    const int hkv = item & 1, qb = (item >> 1) & 31, b = item >> 6;
    const int qr = tid >> 2, qt = tid & 3, qtok = b * SEQ + qb * 128 + qr;
    const bf16_t* qp = PR + (size_t)qtok * NP + C_AQ + (hkv * 4) * 64 + qt * 16;
    u32x4 qw0 = *(const u32x4*)qp, qw1 = *(const u32x4*)(qp + 8);
    float rc[8], rs[8];
    if (qt == 0) {
#pragma unroll
        for (int i = 0; i < 8; ++i) { rc[i] = ROPE[(size_t)qtok * 16 + i]; rs[i] = ROPE[(size_t)qtok * 16 + 8 + i]; } }
    __syncthreads();
    {
        const int r = tid >> 1, half = tid & 1, kpos = qb * 128 - 128 + r;
        u32x4 kw[4], vw[4];
        if (kpos >= 0) { const bf16_t* rp = PR + (size_t)(b * SEQ + kpos) * NP + hkv * 64 + half * 32;
#pragma unroll
            for (int i = 0; i < 4; ++i) { kw[i] = *(const u32x4*)(rp + C_AK + 8 * i); vw[i] = *(const u32x4*)(rp + C_AV + 8 * i); } }
        else {
#pragma unroll
            for (int i = 0; i < 4; ++i) { kw[i] = (u32x4){0u, 0u, 0u, 0u}; vw[i] = (u32x4){0u, 0u, 0u, 0u}; } }
        float x[32];
#pragma unroll
        for (int i = 0; i < 4; ++i) unpack8(kw[i], x + 8 * i);
        float ss = 0.f;
#pragma unroll
        for (int i = 0; i < 32; ++i) ss += x[i] * x[i];
        ss += __shfl_xor(ss, 1);
        const float rstd = rsqrtf(ss * (1.0f / 64.0f) + EPS);
#pragma unroll
        for (int i = 0; i < 32; ++i) x[i] = x[i] * rstd * kn[half * 32 + i];
        if (half == 0 && kpos >= 0) { const float* rt = ROPE + (size_t)(b * SEQ + kpos) * 16;
#pragma unroll
            for (int i = 0; i < 8; ++i) { const float c = rt[i], s = rt[8 + i], x1 = x[i], x2 = x[i + 8]; x[i] = x1 * c - x2 * s; x[i + 8] = x2 * c + x1 * s; } }
#pragma unroll
        for (int i = 0; i < 4; ++i) *(LAS u32x4*)(Ks + r * 72 + half * 32 + 8 * i) = pack8(x + 8 * i);
#pragma unroll
        for (int i = 0; i < 4; ++i) { const unsigned ww[4] = {vw[i].x, vw[i].y, vw[i].z, vw[i].w};
#pragma unroll
            for (int e = 0; e < 4; ++e) { Vt[(half * 32 + 8 * i + 2 * e) * 264 + r] = (bf16_t)(ww[e] & 0xffffu); Vt[(half * 32 + 8 * i + 2 * e + 1) * 264 + r] = (bf16_t)(ww[e] >> 16); } }
    }
    const int q = lane & 15, quad = lane >> 4, qi = 16 * w + q;
    const int kt0 = w < 6 ? w : 6;
    for (int g = 0; g < 4; ++g) {
        const int hq = hkv * 4 + g;
        LDS_BARRIER();
        {
            float x[16]; unpack8(qw0, x); unpack8(qw1, x + 8);
            float ss = 0.f;
#pragma unroll
            for (int i = 0; i < 16; ++i) ss += x[i] * x[i];
            ss += __shfl_xor(ss, 1); ss += __shfl_xor(ss, 2);
            const float rstd = rsqrtf(ss * (1.0f / 64.0f) + EPS);
#pragma unroll
            for (int i = 0; i < 16; ++i) x[i] = x[i] * rstd * qn[qt * 16 + i];
            if (qt == 0) {
#pragma unroll
                for (int i = 0; i < 8; ++i) { const float x1 = x[i], x2 = x[i + 8]; x[i] = x1 * rc[i] - x2 * rs[i]; x[i + 8] = x2 * rc[i] + x1 * rs[i]; } }
#pragma unroll
            for (int i = 0; i < 16; ++i) x[i] *= 0.125f;
            *(LAS u32x4*)(Qs + qr * 72 + qt * 16) = pack8(x); *(LAS u32x4*)(Qs + qr * 72 + qt * 16 + 8) = pack8(x + 8);
        }
        if (g < 3) { qw0 = *(const u32x4*)(qp + (g + 1) * 64); qw1 = *(const u32x4*)(qp + (g + 1) * 64 + 8); }
        LDS_BARRIER();
        bf16x8 qf[2];
#pragma unroll
        for (int ks = 0; ks < 2; ++ks) qf[ks] = *(const LAS bf16x8*)(Qs + qi * 72 + ks * 32 + quad * 8);
        f32x4 st[10];
#pragma unroll
        for (int kt = 0; kt < 10; ++kt) {
            const LAS bf16_t* kr = Ks + (16 * (kt0 + kt) + q) * 72 + quad * 8;
            const bf16x8 k0 = *(const LAS bf16x8*)kr, k1 = *(const LAS bf16x8*)(kr + 32);
            f32x4 a = {0.f, 0.f, 0.f, 0.f};
            a = __builtin_amdgcn_mfma_f32_16x16x32_bf16(k0, qf[0], a, 0, 0, 0);
            a = __builtin_amdgcn_mfma_f32_16x16x32_bf16(k1, qf[1], a, 0, 0, 0);
            st[kt] = a;
        }
        const float sink = sinks[hq];
        float mx = sink;
#pragma unroll
        for (int kt = 0; kt < 10; ++kt)
#pragma unroll
            for (int j = 0; j < 4; ++j) { const int kj = 16 * (kt0 + kt) + quad * 4 + j, delta = qi + 128 - kj;
                const bool valid = (delta >= 0) && (delta < 128) && (qb * 128 + kj - 128 >= 0);
                const float s = valid ? st[kt][j] : -INFINITY; st[kt][j] = s; mx = fmaxf(mx, s); }
        mx = fmaxf(mx, __shfl_xor(mx, 16)); mx = fmaxf(mx, __shfl_xor(mx, 32));
        float sum = 0.f;
#pragma unroll
        for (int kt = 0; kt < 10; ++kt)
#pragma unroll
            for (int j = 0; j < 4; ++j) { const float pv = __expf(st[kt][j] - mx); st[kt][j] = pv; sum += pv; }
        sum += __shfl_xor(sum, 16); sum += __shfl_xor(sum, 32);
        sum += __expf(sink - mx);
        f32x4 ot[4];
#pragma unroll
        for (int dt = 0; dt < 4; ++dt) ot[dt] = (f32x4){0.f, 0.f, 0.f, 0.f};
#pragma unroll
        for (int kk = 0; kk < 5; ++kk) {
            u32x4 pw; pw.x = cvt_pk_bf16(st[2 * kk][0], st[2 * kk][1]); pw.y = cvt_pk_bf16(st[2 * kk][2], st[2 * kk][3]);
            pw.z = cvt_pk_bf16(st[2 * kk + 1][0], st[2 * kk + 1][1]); pw.w = cvt_pk_bf16(st[2 * kk + 1][2], st[2 * kk + 1][3]);
            const bf16x8 pf = __builtin_bit_cast(bf16x8, pw);
#pragma unroll
            for (int dt = 0; dt < 4; ++dt) {
                const LAS bf16_t* vr = Vt + (16 * dt + q) * 264 + 16 * kt0 + 32 * kk + quad * 4;
                const s16x4 lo = *(const LAS s16x4*)vr, hi = *(const LAS s16x4*)(vr + 16);
                const bf16x8 vf = __builtin_shufflevector(lo, hi, 0, 1, 2, 3, 4, 5, 6, 7);
                ot[dt] = __builtin_amdgcn_mfma_f32_16x16x32_bf16(vf, pf, ot[dt], 0, 0, 0);
            }
        }
        const float inv = 1.0f / sum;
        bf16_t* op = MIX + (size_t)(b * SEQ + qb * 128 + qi) * 1024 + hq * 64 + quad * 4;
#pragma unroll
        for (int dt = 0; dt < 4; ++dt) { u32x2 wv; wv.x = cvt_pk_bf16(ot[dt][0] * inv, ot[dt][1] * inv); wv.y = cvt_pk_bf16(ot[dt][2] * inv, ot[dt][3] * inv); *(u32x2*)(op + 16 * dt) = wv; }
    }
}

DI void hgrn_cum(const bf16_t* zp, float lbv, LAS float* tot, int d, int part, float (&cum)[16], float (&kg)[16], float& cmid, float& clast) {
    float run = 0.f, zz[16];
#pragma unroll
    for (int i = 0; i < 16; ++i) zz[i] = bf2f(zp[(size_t)i * NP]);
    if (lbv == 0.f) {
#pragma unroll
        for (int i = 0; i < 16; ++i) {
            const float z = zz[i], e = fexp(-fabsf(z)), inv = frcp(1.0f + e), sn = e * inv;
            kg[i] = z >= 0.f ? sn : inv;
            run += fminf(z, 0.f) - __logf(1.0f + e); cum[i] = run;
        }
    } else {
#pragma unroll
        for (int i = 0; i < 16; ++i) {
            const float z = zz[i], e = fexp(-fabsf(z)), inv = frcp(1.0f + e), sn = e * inv;
            const float sig = z >= 0.f ? inv : sn, oms = z >= 0.f ? sn : inv;
            kg[i] = (1.0f - lbv) * oms;
            run += __logf(lbv + (1.0f - lbv) * sig); cum[i] = run;
        }
    }
    tot[part * 64 + d] = run;
    __syncthreads();
    const float t0 = tot[d], t1 = tot[64 + d], t2 = tot[128 + d], t3 = tot[192 + d];
    const float off = part == 0 ? 0.f : (part == 1 ? t0 : (part == 2 ? t0 + t1 : t0 + t1 + t2));
#pragma unroll
    for (int i = 0; i < 16; ++i) cum[i] += off;
    cmid = t0 + t1; clast = (t0 + t1) + (t2 + t3);
}
DI float hgrn_lb(const Params& p, int l, int idx) {
    if (l == 0) return 0.f;
    const float a0 = p.lb_logits[idx], a1 = p.lb_logits[256 + idx];
    return 1.0f / (1.0f + expf(a0 - a1));
}

DI void phase_hgrn_local(const Params& p, int l, LAS unsigned char* lds) {
    const int tid = opq_tid(), lane = tid & 63, grp = tid >> 8, lt = tid & 255, d = lt & 63, part = lt >> 6, quad = lane >> 4;
    const bf16_t* PR = (const bf16_t*)(p.ws + WS_PROJ);
    float* BST = (float*)(p.ws + WS_BST); float* BDEC = (float*)(p.ws + WS_BDEC);
    LAS unsigned char* gl = lds + grp * 65536;
    LAS bf16_t* kdT = (LAS bf16_t*)gl; LAS bf16_t* Vt = kdT + 64 * LD; LAS float* tot = (LAS float*)(gl + 2 * 64 * LD * 2);
    for (int pr = opq_bid(); pr < NUNIT / 2; pr += opq_gdim()) {
        const int u = pr * 2 + grp, h = u & 3, n = (u >> 2) & 63, b = u >> 8;
        const size_t row0 = (size_t)b * SEQ + n * 64 + part * 16;
        const float lbv = hgrn_lb(p, l, 64 * h + d);
        __syncthreads();
        float cum[16], kg[16], cmid, clast;
        hgrn_cum(PR + row0 * NP + C_BF + 64 * h + d, lbv, tot, d, part, cum, kg, cmid, clast);
        float t[16];
#pragma unroll
        for (int i = 0; i < 16; ++i) t[i] = kg[i] * fexp(clast - cum[i]);
        *(LAS u32x4*)(kdT + d * LD + 16 * part) = pack8(t); *(LAS u32x4*)(kdT + d * LD + 16 * part + 8) = pack8(t + 8);
#pragma unroll
        for (int i = 0; i < 16; ++i) t[i] = bf2f(PR[(row0 + i) * NP + C_BV + 64 * h + d]);
        *(LAS u32x4*)(Vt + d * LD + 16 * part) = pack8(t); *(LAS u32x4*)(Vt + d * LD + 16 * part + 8) = pack8(t + 8);
        if (part == 0) BDEC[(size_t)u * 64 + d] = expf(clast);
        __syncthreads();
        f32x4 acc[4];
#pragma unroll
        for (int nt = 0; nt < 4; ++nt) acc[nt] = (f32x4){0.f, 0.f, 0.f, 0.f};
        mm16x64(acc, kdT + 16 * part * LD, Vt, lane);
        float* Bo = BST + (size_t)u * 4096;
#pragma unroll
        for (int nt = 0; nt < 4; ++nt)
#pragma unroll
            for (int j = 0; j < 4; ++j) Bo[(16 * part + quad * 4 + j) * 64 + 16 * nt + (lane & 15)] = acc[nt][j];
    }
}

DI void phase_hgrn_scan(const Params& p) {
    const float* BST = (const float*)(p.ws + WS_BST); float* BS2 = (float*)(p.ws + WS_BST2); const float* BDEC = (const float*)(p.ws + WS_BDEC);
    for (int idx = opq_bid() * 512 + opq_tid(); idx < 32 * 4096; idx += opq_gdim() * 512) {
        const int chain = idx >> 12, de = idx & 4095, b = chain >> 2, h = chain & 3;
        const size_t o0 = ((size_t)(b * 64) * 4 + h) * 4096 + de; const float* dp = BDEC + ((size_t)(b * 64) * 4 + h) * 64 + (de >> 6);
        float S = 0.f;
#pragma unroll
        for (int n0 = 0; n0 < 64; n0 += 32) {
            float bn[32], dc[32];
#pragma unroll
            for (int i = 0; i < 32; ++i) { bn[i] = BST[o0 + (size_t)(n0 + i) * 4 * 4096]; dc[i] = dp[(size_t)(n0 + i) * 4 * 64]; }
            __builtin_amdgcn_sched_barrier(0);
#pragma unroll
            for (int i = 0; i < 32; ++i) { BS2[o0 + (size_t)(n0 + i) * 4 * 4096] = S; S = dc[i] * S + bn[i]; }
        }
    }
}

DI void phase_hgrn_out(const Params& p, int l, LAS unsigned char* lds, int wg, int nwg) {
    const int tid = opq_tid(), lane = tid & 63, grp = tid >> 8, lt = tid & 255, d = lt & 63, part = lt >> 6, quad = lane >> 4;
    const bf16_t* PR = (const bf16_t*)(p.ws + WS_PROJ);
    bf16_t* MIX = (bf16_t*)(p.ws + WS_H);
    const float* BST = (const float*)(p.ws + WS_BST2);
    const float* hn = p.hgrn_norm + l * 64;
    LAS unsigned char* gl = lds + grp * 65536;
    LAS bf16_t* qs = (LAS bf16_t*)gl; LAS bf16_t* ks = qs + 64 * LD; LAS bf16_t* qcs = ks + 64 * LD; LAS bf16_t* Vt = qcs + 64 * LD; LAS bf16_t* St = Vt + 64 * LD; LAS bf16_t* at = St + 64 * LD;
    LAS float* tot = (LAS float*)(gl + 6 * 64 * LD * 2);
    for (int pr = wg; pr < NUNIT / 2; pr += nwg) {
        const int u = pr * 2 + grp, h = u & 3, n = (u >> 2) & 63, b = u >> 8;
        const size_t row0 = (size_t)b * SEQ + n * 64 + part * 16;
        const float lbv = hgrn_lb(p, l, 64 * h + d);
        __syncthreads();
        float qin[16], vin[16], sin_[16], gin[4][4];
#pragma unroll
        for (int i = 0; i < 16; ++i) { qin[i] = bf2f(PR[(row0 + i) * NP + C_BQ + 64 * h + d]); vin[i] = bf2f(PR[(row0 + i) * NP + C_BV + 64 * h + d]); sin_[i] = BST[(size_t)u * 4096 + (16 * part + i) * 64 + d]; }
#pragma unroll
        for (int j = 0; j < 4; ++j)
#pragma unroll
            for (int nt = 0; nt < 4; ++nt) gin[j][nt] = bf2f(PR[(row0 + quad * 4 + j) * NP + C_BG + 64 * h + 16 * nt + (lane & 15)]);
        float cum[16], kg[16], cmid, clast;
        hgrn_cum(PR + row0 * NP + C_BF + 64 * h + d, lbv, tot, d, part, cum, kg, cmid, clast);
#pragma unroll
        for (int i = 0; i < 16; ++i) { const int t = 16 * part + i; const float qv = qin[i];
            qs[t * LD + d] = f2bf(qv * fexp(cum[i] - cmid)); ks[t * LD + d] = f2bf(kg[i] * fexp(cmid - cum[i])); qcs[t * LD + d] = f2bf(qv * fexp(cum[i])); }
        *(LAS u32x4*)(Vt + d * LD + 16 * part) = pack8(vin); *(LAS u32x4*)(Vt + d * LD + 16 * part + 8) = pack8(vin + 8);
        *(LAS u32x4*)(St + d * LD + 16 * part) = pack8(sin_); *(LAS u32x4*)(St + d * LD + 16 * part + 8) = pack8(sin_ + 8);
        __syncthreads();
        f32x4 acc[4];
#pragma unroll
        for (int nt = 0; nt < 4; ++nt) acc[nt] = (f32x4){0.f, 0.f, 0.f, 0.f};
        mm16x64(acc, qs + 16 * part * LD, ks, lane);
#pragma unroll
        for (int nt = 0; nt < 4; ++nt)
#pragma unroll
            for (int j = 0; j < 4; ++j) { const int t = 16 * part + quad * 4 + j, s = 16 * nt + (lane & 15); at[t * LD + s] = f2bf(s <= t ? acc[nt][j] : 0.f); }
        __syncthreads();
        f32x4 o[4];
#pragma unroll
        for (int nt = 0; nt < 4; ++nt) o[nt] = (f32x4){0.f, 0.f, 0.f, 0.f};
        mm16x64(o, at + 16 * part * LD, Vt, lane);
        mm16x64(o, qcs + 16 * part * LD, St, lane);
#pragma unroll
        for (int j = 0; j < 4; ++j) {
            float ss = o[0][j] * o[0][j] + o[1][j] * o[1][j] + o[2][j] * o[2][j] + o[3][j] * o[3][j];
            ss += __shfl_xor(ss, 1); ss += __shfl_xor(ss, 2); ss += __shfl_xor(ss, 4); ss += __shfl_xor(ss, 8);
            const float rstd = rsqrtf(ss * (1.0f / 64.0f) + EPS);
            const size_t row = (size_t)b * SEQ + n * 64 + 16 * part + quad * 4 + j;
#pragma unroll
            for (int nt = 0; nt < 4; ++nt) { const int e = 16 * nt + (lane & 15);
                MIX[row * 1024 + 512 + 64 * h + e] = f2bf(o[nt][j] * rstd * hn[e] * silu_f(gin[j][nt])); }
        }
    }
}

DI void phase_gdn_local(const Params& p, int l, LAS unsigned char* lds) {
    const int tid = opq_tid(), lane = tid & 63, grp = tid >> 8, lt = tid & 255, d = lt & 63, part = lt >> 6, quad = lane >> 4;
    const bf16_t* PR = (const bf16_t*)(p.ws + WS_PROJ);
    const float* BG = (const float*)(p.ws + WS_BGATE);
    float* CGL = (float*)(p.ws + WS_CGL); bf16_t* CUt = (bf16_t*)(p.ws + WS_CU); bf16_t* CWb = (bf16_t*)(p.ws + WS_CW);
    bf16_t* CKD = (bf16_t*)(p.ws + WS_CKD); bf16_t* CQD = (bf16_t*)(p.ws + WS_CQD); bf16_t* CQK = (bf16_t*)(p.ws + WS_CQK);
    const float* convw = p.conv_w + (size_t)l * 4 * 768;
    LAS unsigned char* gl = lds + grp * 65536;
    LAS float* kf = (LAS float*)gl;
    LAS float* vf = (LAS float*)(gl + 16640);
    LAS bf16_t* qb = (LAS bf16_t*)(gl + 33280);
    LAS bf16_t* kb = qb + 64 * LD;
    LAS float* Am = (LAS float*)(gl + 33280);
    LAS float* Gs = (LAS float*)(gl + 51712);
    LAS float* betas = Gs + 64;
    for (int pr = opq_bid(); pr < NUNIT / 2; pr += opq_gdim()) {
        const int u = pr * 2 + grp, h = u & 3, n = (u >> 2) & 63, b = u >> 8;
        const size_t rowu = (size_t)b * SEQ + n * 64;
        __syncthreads();
        float bb = 0.f, aa = 0.f;
        if (lt < 64) { bb = BG[(rowu + lt) * 8 + h]; aa = BG[(rowu + lt) * 8 + 4 + h]; }
        float cwt[3][4], xin[3][19];
#pragma unroll
        for (int ten = 0; ten < 3; ++ten) {
            const int col = (ten == 0 ? C_CQ : (ten == 1 ? C_CK : C_CV)) + 64 * h + d, ch = ten * 256 + 64 * h + d;
#pragma unroll
            for (int j = 0; j < 4; ++j) cwt[ten][j] = convw[j * 768 + ch];
#pragma unroll
            for (int i = 0; i < 19; ++i) { const int tt = n * 64 + 16 * part + i - 3;
                const float xv = bf2f(PR[((size_t)b * SEQ + (tt > 0 ? tt : 0)) * NP + col]); xin[ten][i] = tt >= 0 ? xv : 0.f; }
        }
        if (lt < 64) {
            const float beta = 1.0f / (1.0f + expf(-bb));
            const float xg = aa + p.dt_bias[l * 4 + h];
            const float sp = fmaxf(xg, 0.f) + log1pf(expf(-fabsf(xg)));
            float g = -expf(p.a_log[l * 4 + h]) * sp;
#pragma unroll
            for (int o = 1; o < 64; o <<= 1) { const float v = __shfl_up(g, o); if (lane >= o) g += v; }
            Gs[lt] = g; betas[lt] = beta;
            if (lt == 63) CGL[u] = expf(g);
        }
        float yq[16], yk[16], sq[16], sk[16];
#pragma unroll
        for (int i = 0; i < 16; ++i) {
            yq[i] = silu_f(cwt[0][0] * xin[0][i] + cwt[0][1] * xin[0][i + 1] + cwt[0][2] * xin[0][i + 2] + cwt[0][3] * xin[0][i + 3]);
            yk[i] = silu_f(cwt[1][0] * xin[1][i] + cwt[1][1] * xin[1][i + 1] + cwt[1][2] * xin[1][i + 2] + cwt[1][3] * xin[1][i + 3]);
            const float yv = silu_f(cwt[2][0] * xin[2][i] + cwt[2][1] * xin[2][i + 1] + cwt[2][2] * xin[2][i + 2] + cwt[2][3] * xin[2][i + 3]);
            vf[(16 * part + i) * 65 + d] = yv;
            sq[i] = yq[i] * yq[i]; sk[i] = yk[i] * yk[i];
        }
#pragma unroll
        for (int i = 0; i < 16; ++i) { sq[i] = wave_sum_dpp(sq[i]); sk[i] = wave_sum_dpp(sk[i]); }
        __syncthreads();
        const float Glast = Gs[63];
        float kdv[16];
#pragma unroll
        for (int i = 0; i < 16; ++i) {
            const int t = 16 * part + i; const float Gt = Gs[t];
            const float qv = yq[i] * rsqrtf(sq[i] + EPS) * 0.125f, nv = yk[i] * rsqrtf(sk[i] + EPS);
            qb[t * LD + d] = f2bf(qv); CQD[(size_t)u * 4096 + t * 64 + d] = f2bf(qv * fexp(Gt));
            kf[t * 65 + d] = nv; kb[t * LD + d] = f2bf(nv); kdv[i] = nv * fexp(Glast - Gt);
        }
        { bf16_t* kp = CKD + (size_t)u * 4096 + d * 64 + 16 * part; *(u32x4*)kp = pack8(kdv); *(u32x4*)(kp + 8) = pack8(kdv + 8); }
        __syncthreads();
        f32x4 kk[4], qk[4];
#pragma unroll
        for (int nt = 0; nt < 4; ++nt) { kk[nt] = (f32x4){0.f, 0.f, 0.f, 0.f}; qk[nt] = (f32x4){0.f, 0.f, 0.f, 0.f}; }
        mm16x64(kk, kb + 16 * part * LD, kb, lane);
        mm16x64(qk, qb + 16 * part * LD, kb, lane);
        __syncthreads();
        {
            float gt[4], bt[4], gs[4];
#pragma unroll
            for (int j = 0; j < 4; ++j) { gt[j] = Gs[16 * part + quad * 4 + j]; bt[j] = betas[16 * part + quad * 4 + j]; gs[j] = Gs[16 * j + (lane & 15)]; }
#pragma unroll
            for (int nt = 0; nt < 4; ++nt)
#pragma unroll
                for (int j = 0; j < 4; ++j) { const int t = 16 * part + quad * 4 + j, s = 16 * nt + (lane & 15);
                    const float ex = fexp(fminf(gt[j] - gs[nt], 0.f));
                    const float L = s <= t ? ex : 0.f;
                    CQK[(size_t)u * 4096 + t * 64 + s] = f2bf(qk[nt][j] * L);
                    Am[t * 68 + s] = s < t ? bt[j] * kk[nt][j] * L : 0.f; }
        }
        __syncthreads();
        if (lt < 128) {
            const int c = lt & 63; const bool isw = lt >= 64;
            float xs[64];
            if (isw) {
#pragma unroll
                for (int i = 0; i < 64; ++i) { xs[i] = kf[i * 65 + c] * betas[i] * fexp(Gs[i]); if ((i & 15) == 15) __builtin_amdgcn_sched_barrier(0); }
            } else {
#pragma unroll
                for (int i = 0; i < 64; ++i) { xs[i] = vf[i * 65 + c] * betas[i]; if ((i & 15) == 15) __builtin_amdgcn_sched_barrier(0); }
            }
#pragma unroll
            for (int i = 1; i < 64; ++i) {
                f32x4 cur[16];
#pragma unroll
                for (int j4 = 0; j4 < (i + 3) / 4; ++j4) cur[j4] = *(const LAS f32x4*)(Am + i * 68 + 4 * j4);
                __builtin_amdgcn_sched_barrier(0);
                float pa[4] = {0.f, 0.f, 0.f, 0.f};
#pragma unroll
                for (int j4 = 0; j4 < (i + 3) / 4; ++j4)
#pragma unroll
                    for (int e = 0; e < 4; ++e) if (4 * j4 + e < i) pa[e] += cur[j4][e] * xs[4 * j4 + e];
                xs[i] -= (pa[0] + pa[1]) + (pa[2] + pa[3]);
                __builtin_amdgcn_sched_barrier(0);
            }
            if (isw) { bf16_t* dstW = CWb + (size_t)u * 4096 + c;
#pragma unroll
                for (int i = 0; i < 64; ++i) dstW[i * 64] = f2bf(xs[i]); }
            else { bf16_t* up = CUt + (size_t)u * 4096 + c * 64;
#pragma unroll
                for (int i8 = 0; i8 < 8; ++i8) *(u32x4*)(up + 8 * i8) = pack8(xs + 8 * i8); }
        } else {
            const int half = (lt >> 6) - 2; const float gnd = p.gdn_norm[l * 64 + d];
            float gin[32];
#pragma unroll
            for (int i = 0; i < 32; ++i) gin[i] = bf2f(PR[(rowu + 32 * half + i) * NP + C_CG + 64 * h + d]);
#pragma unroll
            for (int i = 0; i < 32; ++i) gin[i] = silu_f(gin[i]) * gnd;
            bf16_t* gp = (bf16_t*)(p.ws + WS_CO) + (size_t)u * 4096 + (32 * half) * 64 + d;
#pragma unroll
            for (int i = 0; i < 32; ++i) gp[i * 64] = f2bf(gin[i]);
        }
    }
}

DI void mm64x16_t(f32x4 (&acc)[4], const LAS bf16_t* E, const LAS bf16_t* Trow, int lane) {
    const int r = lane & 15, q = lane >> 4;
    bf16x8 b[2], a[2][4];
#pragma unroll
    for (int ks = 0; ks < 2; ++ks) { b[ks] = *(const LAS bf16x8*)(Trow + r * LD + ks * 32 + q * 8);
#pragma unroll
        for (int et = 0; et < 4; ++et) a[ks][et] = *(const LAS bf16x8*)(E + (et * 16 + r) * LD + ks * 32 + q * 8); }
    __builtin_amdgcn_sched_barrier(0);
#pragma unroll
    for (int ks = 0; ks < 2; ++ks)
#pragma unroll
        for (int et = 0; et < 4; ++et) acc[et] = __builtin_amdgcn_mfma_f32_16x16x32_bf16(a[ks][et], b[ks], acc[et], 0, 0, 0);
    __builtin_amdgcn_sched_barrier(0);
}
struct ScanRegs { u32x4 w, kd, qd, qk, ut, gt; };
constexpr int TILE_E = 64 * LD;
DI void scan_issue(ScanRegs& r, const Params& p, int b, int h, int m, int tid) {
    const size_t u = (size_t)(b * 64 + (m < 64 ? m : 63)) * 4 + h;
    r.w = *(const u32x4*)((const bf16_t*)(p.ws + WS_CW) + u * 4096 + tid * 8); r.kd = *(const u32x4*)((const bf16_t*)(p.ws + WS_CKD) + u * 4096 + tid * 8);
    r.qd = *(const u32x4*)((const bf16_t*)(p.ws + WS_CQD) + u * 4096 + tid * 8); r.qk = *(const u32x4*)((const bf16_t*)(p.ws + WS_CQK) + u * 4096 + tid * 8);
    r.ut = *(const u32x4*)((const bf16_t*)(p.ws + WS_CU) + u * 4096 + tid * 8);
    r.gt = *(const u32x4*)((const bf16_t*)(p.ws + WS_CO) + u * 4096 + tid * 8);
}
DI void scan_store(const ScanRegs& r, LAS bf16_t* buf, int tid) {
    const int off = (tid >> 3) * LD + (tid & 7) * 8;
    *(LAS u32x4*)(buf + off) = r.w; *(LAS u32x4*)(buf + TILE_E + off) = r.kd; *(LAS u32x4*)(buf + 2 * TILE_E + off) = r.qd; *(LAS u32x4*)(buf + 3 * TILE_E + off) = r.qk;
    *(LAS u32x4*)(buf + 4 * TILE_E + off) = r.ut; *(LAS u32x4*)(buf + 5 * TILE_E + off) = r.gt;
}
DI void gdn_scan_chain(const Params& p, int l, LAS unsigned char* lds, int chain) {
    const int tid = opq_tid(), lane = tid & 63, w = tid >> 6, quad = lane >> 4, r16 = lane & 15, mt = w & 3;
    bf16_t* MIX = (bf16_t*)(p.ws + WS_H);
    LAS bf16_t* buf0 = (LAS bf16_t*)lds; LAS bf16_t* buf1 = buf0 + 6 * TILE_E; LAS bf16_t* St = buf1 + 6 * TILE_E; LAS bf16_t* VNt = St + TILE_E;
    const int b = chain >> 2, h = chain & 3, urow = 16 * mt + quad * 4;
    f32x4 SG[4];
#pragma unroll
    for (int nt = 0; nt < 4; ++nt) SG[nt] = (f32x4){0.f, 0.f, 0.f, 0.f};
    ScanRegs R0, R1, R2, R3;
    scan_issue(R0, p, b, h, 0, tid); scan_issue(R1, p, b, h, 1, tid); scan_issue(R2, p, b, h, 2, tid); scan_issue(R3, p, b, h, 3, tid);
    LAS float* GLs = (LAS float*)(VNt + TILE_E);
    LAS bf16_t* Os = VNt + TILE_E + 128;
    bf16_t* mixp = MIX + ((size_t)b * SEQ + (tid >> 3)) * 1024 + 768 + 64 * h + (tid & 7) * 8;
    __syncthreads();
    scan_store(R0, buf0, tid);
    if (tid < 64) GLs[tid] = ((const float*)(p.ws + WS_CGL))[(size_t)(b * 64 + tid) * 4 + h];
    if (w < 4) {
#pragma unroll
        for (int nt = 0; nt < 4; ++nt) *(LAS u32x2*)(St + (16 * nt + r16) * LD + urow) = (u32x2){0u, 0u};
    }
    __syncthreads();
#define GDN_STEP(k, RC, RN, BC, BN) do { const int m = n + (k); \
        *(u32x4*)(mixp + (size_t)(m > 0 ? m - 1 : 0) * 64 * 1024) = *(const LAS u32x4*)(Os + (tid >> 3) * LD + (tid & 7) * 8); \
        scan_issue(RC, p, b, h, m + 4, tid); \
        f32x4 AC[4]; _Pragma("unroll") for (int nt = 0; nt < 4; ++nt) AC[nt] = (f32x4){0.f, 0.f, 0.f, 0.f}; \
        if (w < 4) { u32x2 uwv[4]; _Pragma("unroll") for (int nt = 0; nt < 4; ++nt) uwv[nt] = *(const LAS u32x2*)(BC + 4 * TILE_E + (16 * nt + r16) * LD + urow); \
            mm16x64(AC, BC + 16 * mt * LD, St, lane); \
            _Pragma("unroll") for (int nt = 0; nt < 4; ++nt) { float uu[4]; { const u32x2 uw = uwv[nt]; \
                    uu[0] = __uint_as_float(uw.x << 16); uu[1] = __uint_as_float(uw.x & 0xffff0000u); uu[2] = __uint_as_float(uw.y << 16); uu[3] = __uint_as_float(uw.y & 0xffff0000u); } \
                u32x2 pv; pv.x = cvt_pk_bf16(uu[0] - AC[nt][0], uu[1] - AC[nt][1]); pv.y = cvt_pk_bf16(uu[2] - AC[nt][2], uu[3] - AC[nt][3]); *(LAS u32x2*)(VNt + (16 * nt + r16) * LD + urow) = pv; \
                AC[nt] = (f32x4){0.f, 0.f, 0.f, 0.f}; } } \
        else { mm64x16_t(AC, St, BC + 2 * TILE_E + 16 * mt * LD, lane); } \
        LDS_BARRIER(); \
        if (w < 4) { const float gl = GLs[m]; mm16x64(AC, BC + TILE_E + 16 * mt * LD, VNt, lane); \
            _Pragma("unroll") for (int nt = 0; nt < 4; ++nt) { SG[nt] = SG[nt] * gl + AC[nt]; \
                u32x2 pv; pv.x = cvt_pk_bf16(SG[nt][0], SG[nt][1]); pv.y = cvt_pk_bf16(SG[nt][2], SG[nt][3]); *(LAS u32x2*)(St + (16 * nt + r16) * LD + urow) = pv; } } \
        else { u32x2 gwv[4]; _Pragma("unroll") for (int et = 0; et < 4; ++et) gwv[et] = *(const LAS u32x2*)(BC + 5 * TILE_E + (16 * mt + r16) * LD + 16 * et + 4 * quad); \
            mm64x16_t(AC, VNt, BC + 3 * TILE_E + 16 * mt * LD, lane);        \
            float ss = 0.f; \
            _Pragma("unroll") for (int et = 0; et < 4; ++et) ss += (AC[et][0] * AC[et][0] + AC[et][1] * AC[et][1]) + (AC[et][2] * AC[et][2] + AC[et][3] * AC[et][3]); \
            ss = xrow4_sum(ss); \
            const float rstd = rsqrtf(ss * (1.0f / 64.0f) + EPS); \
            _Pragma("unroll") for (int et = 0; et < 4; ++et) { const u32x2 gw = gwv[et]; \
                u32x2 ov; ov.x = cvt_pk_bf16(AC[et][0] * rstd * __uint_as_float(gw.x << 16), AC[et][1] * rstd * __uint_as_float(gw.x & 0xffff0000u)); \
                ov.y = cvt_pk_bf16(AC[et][2] * rstd * __uint_as_float(gw.y << 16), AC[et][3] * rstd * __uint_as_float(gw.y & 0xffff0000u)); \
                *(LAS u32x2*)(Os + (16 * mt + r16) * LD + 16 * et + 4 * quad) = ov; } } \
        scan_store(RN, BN, tid); \
        LDS_BARRIER(); } while (0)
    for (int n = 0; n < 64; n += 4) {
        GDN_STEP(0, R0, R1, buf0, buf1); GDN_STEP(1, R1, R2, buf1, buf0); GDN_STEP(2, R2, R3, buf0, buf1); GDN_STEP(3, R3, R0, buf1, buf0);
    }
    *(u32x4*)(mixp + (size_t)63 * 64 * 1024) = *(const LAS u32x4*)(Os + (tid >> 3) * LD + (tid & 7) * 8);
#undef GDN_STEP
}

DI void phase_gdn_norm(const Params& p, int l) {
    const int tid = opq_tid(), lane = tid & 63, wave = tid >> 6;
    const bf16_t* PR = (const bf16_t*)(p.ws + WS_PROJ);
    bf16_t* MIX = (bf16_t*)(p.ws + WS_H);
    const float* CO = (const float*)(p.ws + WS_CO);
    const float gn = p.gdn_norm[l * 64 + lane];
    for (int row = opq_bid() * 8 + wave; row < MT; row += opq_gdim() * 8) {
        float v[4], g[4];
#pragma unroll
        for (int h = 0; h < 4; ++h) { v[h] = CO[(size_t)row * 256 + 64 * h + lane]; g[h] = bf2f(PR[(size_t)row * NP + C_CG + 64 * h + lane]); }
#pragma unroll
        for (int h = 0; h < 4; ++h) { const float ss = wave_sum(v[h] * v[h]);
            MIX[(size_t)row * 1024 + 768 + 64 * h + lane] = f2bf(v[h] * rsqrtf(ss * (1.0f / 64.0f) + EPS) * gn * silu_f(g[h])); }
    }
}

#define XB_TMO      128
#define XB_XCNT(j)  (256  + 64 * (j))
#define XB_XSUB(j)  (1280 + 64 * (j))
#define XB_XGEN(j)  (2304 + 64 * (j))
#define XB_TOP      3328
#define XB_TOPGEN   3392
#define XCD_BAR_WORDS 3456
#define XB_SPIN_CAP (1u << 18)

__device__ __forceinline__ unsigned xb_ld(unsigned* p)              { return __hip_atomic_load(p, __ATOMIC_RELAXED, __HIP_MEMORY_SCOPE_AGENT); }
__device__ __forceinline__ unsigned xb_add(unsigned* p, unsigned v) { return __hip_atomic_fetch_add(p, v, __ATOMIC_RELAXED, __HIP_MEMORY_SCOPE_AGENT); }
__device__ __forceinline__ unsigned xb_xcc_id() { return (unsigned)__builtin_amdgcn_s_getreg((3 << 11) | 20) & 0xFu; }
#define XB_SPIN(cond, bar) do { unsigned _sp = 0; while (cond) { __builtin_amdgcn_s_sleep(1); \
    if ((++_sp & 255u) == 0u) { if (xb_ld(&(bar)[XB_TMO])) break; if (_sp > XB_SPIN_CAP) { atomicAdd(&(bar)[XB_TMO], 1u); break; } } } } while (0)

struct XcdBarrier {
    unsigned* bar; unsigned x;
    volatile LAS unsigned* st;
};

__device__ __forceinline__ XcdBarrier xcd_barrier_post(unsigned* bar, volatile LAS unsigned* st) {
    XcdBarrier b; b.bar = bar; b.x = xb_xcc_id(); b.st = st;
    if (threadIdx.x == 0) (void)xb_add(&bar[XB_XCNT(b.x)], 1u);
    return b;
}
__device__ __forceinline__ void xcd_barrier_complete(unsigned* bar, unsigned x, unsigned& nloc, unsigned& nx) {
    const unsigned G = gridDim.x * gridDim.y * gridDim.z;
    unsigned sum, cnt, mine, sp = 0u;
    for (;;) {
        sum = 0u; cnt = 0u; mine = 0u;
#pragma unroll
        for (unsigned j = 0; j < 16; ++j) { const unsigned c = xb_ld(&bar[XB_XCNT(j)]); sum += c; cnt += (c > 0u) ? 1u : 0u; mine = (j == x) ? c : mine; }
        if (sum == G) break;
        __builtin_amdgcn_s_sleep(1);
        if ((++sp & 255u) == 0u) { if (xb_ld(&bar[XB_TMO])) break; if (sp > XB_SPIN_CAP) { atomicAdd(&bar[XB_TMO], 1u); break; } }
    }
    nloc = mine > 0u ? mine : 1u; nx = cnt > 0u ? cnt : 1u;
}

__device__ __forceinline__ void xcd_barrier(const XcdBarrier& b) {
    asm volatile("s_waitcnt vmcnt(0)" ::: "memory");
    __syncthreads();
    if (threadIdx.x == 0) {
        unsigned* bar = b.bar;
        __builtin_amdgcn_s_waitcnt(0);
        unsigned nloc = b.st[0], nx = b.st[1];
        if (nloc == 0u) { xcd_barrier_complete(bar, b.x, nloc, nx); b.st[0] = nloc; b.st[1] = nx; }
        const unsigned old = xb_add(&bar[XB_XSUB(b.x)], 1u);
        const unsigned gen = old / nloc;
        if (old + 1u == (gen + 1u) * nloc) {
            __builtin_amdgcn_fence(__ATOMIC_RELEASE, "agent");
            asm volatile("s_waitcnt vmcnt(0)" ::: "memory");
            const unsigned og = xb_add(&bar[XB_TOP], 1u);
            const unsigned tg = og / nx;
            if (og + 1u == (tg + 1u) * nx) xb_add(&bar[XB_TOPGEN], 1u);
            else XB_SPIN(xb_ld(&bar[XB_TOPGEN]) == tg, bar);
            __builtin_amdgcn_fence(__ATOMIC_ACQUIRE, "agent");
            xb_add(&bar[XB_XGEN(b.x)], 1u);
            asm volatile("s_waitcnt vmcnt(0)" ::: "memory");
        } else {
            XB_SPIN(xb_ld(&bar[XB_XGEN(b.x)]) == gen, bar);
            __builtin_amdgcn_fence(__ATOMIC_ACQUIRE, "agent");
            asm volatile("s_waitcnt vmcnt(0)" ::: "memory");
        }
    }
    __syncthreads();
}

__global__ void __launch_bounds__(512, 2) fwd_kernel(Params p) {
    extern __shared__ __attribute__((aligned(16))) unsigned char lds_raw[];
    LAS unsigned char* lds = (LAS unsigned char*)lds_raw;
    const int G = opq_gdim();
    float* MOD = (float*)(p.ws + WS_MOD);
    bf16_t* H = (bf16_t*)(p.ws + WS_H);
    bf16_t* PROJ = (bf16_t*)(p.ws + WS_PROJ);
    unsigned* barw = (unsigned*)(p.ws + WS_BAR);
    volatile LAS unsigned* bst = (volatile LAS unsigned*)(lds + LDS_MISC);
    if (opq_tid() == 0) { bst[0] = 0u; bst[1] = 0u; }
    __syncthreads();
    XcdBarrier bar = xcd_barrier_post(barw, bst);
    for (int ph = p.ph_lo; ph < p.ph_hi; ++ph) {
        if (ph == 0) { phase_prologue(p, lds); continue; }
        if (ph > p.ph_lo) xcd_barrier(bar);
        const int l = (ph - 1) / 9, s = (ph - 1) % 9;
        const float* mod_l = MOD + (size_t)l * 8 * 6144;
        const bf16_t* WL = (const bf16_t*)(p.ws + WS_W) + (size_t)l * W_LAYER;
        const float* xin = (l == 0) ? p.x : p.out;
        if (EN(1) && s == 0) { phase_norm<true>(xin, p.norm_mix + l * DM, mod_l, 0, 1024, H, p.w_in + (size_t)l * 1024 * DIN, (float*)(p.ws + WS_BGATE)); }
        else if (EN(2) && s == 1) { pg8::Gemm g{H, WL + W_IN, MT, NP, DM}; pg8::StaticOrder S; S.init(MT, NP, G, opq_bid()); pg8::EpiStoreBf16 E{PROJ, NP};
            pg8::gemm_phase<pg8::EpiStoreBf16, pg8::StaticOrder, true, true>(lds, g, S, E); }
        else if (EN(3) && s == 2) { phase_hgrn_local(p, l, lds); __syncthreads(); phase_gdn_local(p, l, lds); }
        else if (EN(4) && s == 3) { phase_hgrn_scan(p); }
        else if (EN(5) && s == 4) {
            unsigned* ctr = barw + XCD_BAR_WORDS + 64 * (l + 1);
            volatile LAS int* qslot = (volatile LAS int*)(lds + LDS_MISC + 64);
            for (;;) {
                __syncthreads();
                if (opq_tid() == 0) *qslot = (int)__hip_atomic_fetch_add(ctr, 1u, __ATOMIC_RELAXED, __HIP_MEMORY_SCOPE_AGENT);
                __syncthreads();
                const int idx = *qslot;
                if (idx >= 32 + 512 + NUNIT / 2) break;
                if (idx < 32) gdn_scan_chain(p, l, lds, idx);
                else if (idx < 32 + 512) attn_item(p, l, lds, idx - 32);
                else phase_hgrn_out(p, l, lds, idx - (32 + 512), 1 << 30);
            }
        }
        else if (EN(6) && s == 5) { pg8::Gemm g{H, WL + W_OUT, MT, DM, DM}; pg8::StaticOrder S; S.init(MT, DM, G, opq_bid()); pg8::EpiGateRes E{xin, p.out, DM, mod_l + 2048, 6144, SEQ};
            pg8::gemm_phase<pg8::EpiGateRes, pg8::StaticOrder, true, true>(lds, g, S, E); }
        else if (EN(7) && s == 6) { phase_norm<false>(p.out, p.norm_ffn + l * DM, mod_l, 3072, 4096, H, nullptr, nullptr); }
        else if (EN(8) && s == 7) { pg8::Gemm g{H, WL + W_GU, MT, 2 * DFF, DM}; pg8::StaticOrder S; S.init(MT, 2 * DFF, G, opq_bid()); pg8::EpiSwiGlu E{PROJ, DFF};
            pg8::gemm_phase<pg8::EpiSwiGlu, pg8::StaticOrder, true, true>(lds, g, S, E); }
        else if (EN(9)) { pg8::Gemm g{PROJ, WL + W_DN, MT, DM, DFF}; pg8::StaticOrder S; S.init(MT, DM, G, opq_bid()); pg8::EpiGateRes E{p.out, p.out, DM, mod_l + 5120, 6144, SEQ};
            pg8::gemm_phase<pg8::EpiGateRes, pg8::StaticOrder, true, true>(lds, g, S, E); }
    }
}

extern "C" void kernel_launch(void* const* d_in, const int* in_sizes, int n_in, void* d_out, int out_size, void* d_ws, size_t ws_size, hipStream_t stream) {
    static int grid = 0;
    if (grid == 0) {
        if (n_in != 21 || in_sizes[0] != MT * DM || out_size != MT * DM || ws_size < WS_END) { fprintf(stderr, "kernel_launch: unexpected shapes (n_in %d, in0 %d, out %d, ws %zu)\n", n_in, n_in > 0 ? in_sizes[0] : -1, out_size, ws_size); grid = -1; return; }
        int dev = 0, cus = 0, per_cu = 0;
        if (hipGetDevice(&dev) != hipSuccess || hipDeviceGetAttribute(&cus, hipDeviceAttributeMultiprocessorCount, dev) != hipSuccess) { grid = -1; return; }
        if (hipFuncSetAttribute((const void*)fwd_kernel, hipFuncAttributeMaxDynamicSharedMemorySize, LDS_BYTES) != hipSuccess) { fprintf(stderr, "kernel_launch: hipFuncSetAttribute failed\n"); grid = -1; return; }
        if (hipOccupancyMaxActiveBlocksPerMultiprocessor(&per_cu, (const void*)fwd_kernel, 512, LDS_BYTES) != hipSuccess || per_cu < 1) { fprintf(stderr, "kernel_launch: occupancy query says %d\n", per_cu); (void)hipGetLastError(); per_cu = 1; }
        grid = cus * per_cu;
    }
    if (grid < 0) return;
    Params p{};
    p.x = (const float*)d_in[0]; p.c = (const float*)d_in[1]; p.pos = (const int*)d_in[2]; p.ada_w = (const float*)d_in[3]; p.ada_b = (const float*)d_in[4];
    p.norm_mix = (const float*)d_in[5]; p.w_in = (const float*)d_in[6]; p.qn = (const float*)d_in[7]; p.kn = (const float*)d_in[8]; p.sinks = (const float*)d_in[9];
    p.lb_logits = (const float*)d_in[10]; p.hgrn_norm = (const float*)d_in[11]; p.conv_w = (const float*)d_in[12]; p.a_log = (const float*)d_in[13]; p.dt_bias = (const float*)d_in[14];
    p.gdn_norm = (const float*)d_in[15]; p.w_out = (const float*)d_in[16]; p.norm_ffn = (const float*)d_in[17]; p.w_gate = (const float*)d_in[18]; p.w_up = (const float*)d_in[19];
    p.w_down = (const float*)d_in[20]; p.out = (float*)d_out; p.ws = (unsigned char*)d_ws;
    p.ph_lo = 0; p.ph_hi = NPHASE;
    if (hipMemsetAsync((char*)d_ws + WS_BAR, 0, (XCD_BAR_WORDS + 256) * sizeof(unsigned), stream) != hipSuccess) { fprintf(stderr, "kernel_launch: hipMemsetAsync of the barrier words failed\n"); return; }
    void* args[] = {&p};
    const hipError_t e = hipLaunchCooperativeKernel((const void*)fwd_kernel, dim3(grid), dim3(512), args, LDS_BYTES, stream);
    if (e != hipSuccess) fprintf(stderr, "kernel_launch: cooperative launch failed: %s (grid %d)\n", hipGetErrorString(e), grid);
}
```
